# Optimizing an MI355X kernel written in HIP

```python
import math
import jax, jax.numpy as jnp
from jax import lax
import numpy as np

D_MODEL = 1024
BATCH = 16
SEQ = 2048
DEPTH = 2

HEAD_DIM = 64
D_MIX = D_MODEL
DIFF_WIDTH = D_MIX // 2
DIFF_HEADS = DIFF_WIDTH // (2 * HEAD_DIM)
SWA_WIDTH = D_MIX - DIFF_WIDTH
SWA_HEADS = SWA_WIDTH // HEAD_DIM
SWA_KV_HEADS = 2
SWA_GROUP = SWA_HEADS // SWA_KV_HEADS
WINDOW = 128
BLOCK = 128
ROPE_THETA = 10000.0
D_FF = -(-8 * D_MODEL // (3 * 256)) * 256
EPS = 1e-6
NEG = -1e30

DQ_DIFF = DIFF_HEADS * 2 * HEAD_DIM
DK_DIFF = DIFF_HEADS * 2 * HEAD_DIM
DV_DIFF = DIFF_HEADS * 2 * HEAD_DIM
DQ_SWA = SWA_HEADS * HEAD_DIM
DK_SWA = SWA_KV_HEADS * HEAD_DIM
DV_SWA = SWA_KV_HEADS * HEAD_DIM
SPLITS = tuple(np.cumsum([DQ_DIFF, DK_DIFF, DV_DIFF, DQ_SWA, DK_SWA])[:].tolist())
D_IN_PROJ = DQ_DIFF + DK_DIFF + DV_DIFF + DQ_SWA + DK_SWA + DV_SWA

kernel_name = "hymba_diffattn_swa_sink_sandwich_adaln"


def rmsnorm(x, g):
    xf = x.astype(jnp.float32)
    xf = xf * lax.rsqrt(jnp.mean(xf * xf, axis=-1, keepdims=True) + EPS)
    return (xf * g.astype(jnp.float32)).astype(x.dtype)


def rope_tables(seq):
    pos = jnp.arange(seq, dtype=jnp.float32)
    inv = ROPE_THETA ** (-jnp.arange(0, HEAD_DIM, 2, dtype=jnp.float32) / HEAD_DIM)
    ang = pos[:, None] * inv[None, :]
    return jnp.cos(ang), jnp.sin(ang)


def apply_rope(x, cos, sin):
    xf = x.astype(jnp.float32)
    x1, x2 = xf[..., : HEAD_DIM // 2], xf[..., HEAD_DIM // 2:]
    c, s = cos[None, :, None, :], sin[None, :, None, :]
    return jnp.concatenate([x1 * c - x2 * s, x2 * c + x1 * s], axis=-1).astype(x.dtype)


def diff_attention(q, k, v, lam, lam_init, subln_g, cos, sin):
    B, S = q.shape[0], q.shape[1]
    q = apply_rope(q.reshape(B, S, DIFF_HEADS * 2, HEAD_DIM), cos, sin).reshape(B, S, DIFF_HEADS, 2, HEAD_DIM)
    k = apply_rope(k.reshape(B, S, DIFF_HEADS * 2, HEAD_DIM), cos, sin).reshape(B, S, DIFF_HEADS, 2, HEAD_DIM)
    v = v.reshape(B, S, DIFF_HEADS, 2 * HEAD_DIM)
    scale = HEAD_DIM ** -0.5
    outs = []
    for i in range(S // BLOCK):
        lo, hi = i * BLOCK, (i + 1) * BLOCK
        s = jnp.einsum('bqhmd,bkhmd->bhmqk', q[:, lo:hi], k[:, :hi]).astype(jnp.float32) * scale
        mask = jnp.arange(hi)[None, :] <= jnp.arange(lo, hi)[:, None]
        p = jax.nn.softmax(jnp.where(mask, s, NEG), axis=-1)
        a = (p[:, :, 0] - lam * p[:, :, 1]).astype(v.dtype)
        outs.append(jnp.einsum('bhqk,bkhe->bqhe', a, v[:, :hi]))
    o = jnp.concatenate(outs, axis=1)
    o = rmsnorm(o, subln_g) * (1.0 - lam_init)
    return o.reshape(B, S, DIFF_WIDTH)


def swa_sink_attention(q, k, v, sinks, cos, sin):
    B, S = q.shape[0], q.shape[1]
    nb = S // BLOCK
    q = apply_rope(q.reshape(B, S, SWA_HEADS, HEAD_DIM), cos, sin)
    q = q.reshape(B, nb, BLOCK, SWA_KV_HEADS, SWA_GROUP, HEAD_DIM)
    k = apply_rope(k.reshape(B, S, SWA_KV_HEADS, HEAD_DIM), cos, sin)
    v = v.reshape(B, S, SWA_KV_HEADS, HEAD_DIM)

    def band(t):
        tp = jnp.pad(t, ((0, 0), (BLOCK, 0), (0, 0), (0, 0))).reshape(B, nb + 1, BLOCK, SWA_KV_HEADS, HEAD_DIM)
        return jnp.concatenate([tp[:, :-1], tp[:, 1:]], axis=2)

    kw, vw = band(k), band(v)
    s = jnp.einsum('bnqhgd,bnkhd->bnhgqk', q, kw).astype(jnp.float32) * (HEAD_DIM ** -0.5)
    r = jnp.arange(BLOCK)[:, None]
    j = jnp.arange(2 * BLOCK)[None, :]
    dist = BLOCK + r - j
    kpos = jnp.arange(nb)[:, None, None] * BLOCK - BLOCK + j[None]
    mask = (dist >= 0)[None] & (dist < WINDOW)[None] & (kpos >= 0)
    s = jnp.where(mask[None, :, None, None], s, NEG)
    sink = jnp.broadcast_to(sinks.astype(jnp.float32).reshape(1, 1, SWA_KV_HEADS, SWA_GROUP, 1, 1),
                            s.shape[:-1] + (1,))
    p = jax.nn.softmax(jnp.concatenate([s, sink], axis=-1), axis=-1)[..., :-1].astype(v.dtype)
    o = jnp.einsum('bnhgqk,bnkhd->bnqhgd', p, vw)
    return o.reshape(B, S, SWA_WIDTH)


def token_mixer(h, w_in, w_out, lam, lam_init, subln_g, sinks, cos, sin):
    proj = jnp.einsum('bsd,de->bse', h, w_in)
    qd, kd, vd, qs, ks, vs = jnp.split(proj, SPLITS, axis=-1)
    o_diff = diff_attention(qd, kd, vd, lam, lam_init, subln_g, cos, sin)
    o_swa = swa_sink_attention(qs, ks, vs, sinks, cos, sin)
    o = jnp.concatenate([o_diff, o_swa], axis=-1)
    return jnp.einsum('bse,ed->bsd', o, w_out)


def swiglu(h, w_gate, w_up, w_down):
    g = jnp.einsum('bsd,df->bsf', h, w_gate)
    u = jnp.einsum('bsd,df->bsf', h, w_up)
    return jnp.einsum('bsf,fd->bsd', jax.nn.silu(g) * u, w_down)


def setup_inputs(seed: int = 0) -> dict:
    key = jax.random.key(seed)
    ks = jax.random.split(key, 20)
    f32 = jnp.float32
    nrm = lambda k, shape, s: jax.random.normal(k, shape, f32) * s
    gain = lambda k, shape: 1.0 + 0.02 * jax.random.normal(k, shape, f32)
    return {
        "x": nrm(ks[0], (BATCH, SEQ, D_MODEL), 1.0),
        "c": nrm(ks[1], (BATCH, D_MODEL), 1.0),
        "ada_w": nrm(ks[2], (DEPTH, D_MODEL, 6 * D_MODEL), 0.5 * D_MODEL ** -0.5),
        "ada_b": nrm(ks[3], (DEPTH, 6 * D_MODEL), 0.02),
        "g_mix_pre": gain(ks[4], (DEPTH, D_MODEL)),
        "g_mix_post": gain(ks[5], (DEPTH, D_MODEL)),
        "g_ffn_pre": gain(ks[6], (DEPTH, D_MODEL)),
        "g_ffn_post": gain(ks[7], (DEPTH, D_MODEL)),
        "w_in": nrm(ks[8], (DEPTH, D_MODEL, D_IN_PROJ), D_MODEL ** -0.5),
        "lambda_q1": nrm(ks[9], (DEPTH, HEAD_DIM), 0.1),
        "lambda_k1": nrm(ks[10], (DEPTH, HEAD_DIM), 0.1),
        "lambda_q2": nrm(ks[11], (DEPTH, HEAD_DIM), 0.1),
        "lambda_k2": nrm(ks[12], (DEPTH, HEAD_DIM), 0.1),
        "subln_g": gain(ks[13], (DEPTH, 2 * HEAD_DIM)),
        "sinks": nrm(ks[14], (DEPTH, SWA_HEADS), 0.5),
        "w_out": nrm(ks[15], (DEPTH, D_MIX, D_MODEL), D_MIX ** -0.5),
        "w_gate": nrm(ks[16], (DEPTH, D_MODEL, D_FF), D_MODEL ** -0.5),
        "w_up": nrm(ks[17], (DEPTH, D_MODEL, D_FF), D_MODEL ** -0.5),
        "w_down": nrm(ks[18], (DEPTH, D_FF, D_MODEL), D_FF ** -0.5),
    }


def reference(x, c, ada_w, ada_b, g_mix_pre, g_mix_post, g_ffn_pre, g_ffn_post, w_in,
              lambda_q1, lambda_k1, lambda_q2, lambda_k2, subln_g, sinks, w_out,
              w_gate, w_up, w_down):
    S = x.shape[1]
    cos, sin = rope_tables(S)
    c_act = jax.nn.silu(c)
    for l in range(DEPTH):
        mod = jnp.einsum('bd,de->be', c_act, ada_w[l]) + ada_b[l]
        sh1, sc1, gt1, sh2, sc2, gt2 = [m[:, None, :] for m in jnp.split(mod, 6, axis=-1)]
        lam_init = 0.8 - 0.6 * math.exp(-0.3 * l)
        lam = (jnp.exp(jnp.sum(lambda_q1[l].astype(jnp.float32) * lambda_k1[l].astype(jnp.float32)))
               - jnp.exp(jnp.sum(lambda_q2[l].astype(jnp.float32) * lambda_k2[l].astype(jnp.float32)))
               + lam_init)
        h = rmsnorm(x, g_mix_pre[l]) * (1.0 + sc1) + sh1
        y = token_mixer(h, w_in[l], w_out[l], lam, lam_init, subln_g[l], sinks[l], cos, sin)
        x = x + gt1 * rmsnorm(y, g_mix_post[l])
        h = rmsnorm(x, g_ffn_pre[l]) * (1.0 + sc2) + sh2
        y = swiglu(h, w_gate[l], w_up[l], w_down[l])
        x = x + gt2 * rmsnorm(y, g_ffn_post[l])
    return x
```

```cpp
#include <hip/hip_runtime.h>
#include <hip/hip_cooperative_groups.h>
#include <cstdio>
#include <cstdint>
#include <type_traits>
namespace cg = cooperative_groups;

namespace pg8 {
#define PG8_LAS __attribute__((address_space(3)))
typedef unsigned short bf16_t;
typedef short bf16x8 __attribute__((ext_vector_type(8)));
typedef float f32x4 __attribute__((ext_vector_type(4)));
typedef unsigned u32x4 __attribute__((ext_vector_type(4)));
constexpr int BM = 256, BK = 64, HALF = 128, HTB = HALF * BK * 2  , STAGE_BYTES = 8 * HTB, NXCD = 8, WGM = 8;

__host__ __device__ __forceinline__ int lds_byte(int r, int c) { const int st = (r >> 4) * 2 + (c >> 5), rr = r & 15, cc = c & 31, ob = rr * 64 + cc * 2; return st * 1024 + (ob ^ (((ob >> 9) & 1) << 5)); }
__host__ __device__ __forceinline__ void stage_rc(int b, int& R, int& C) { const int st = b / 1024, sb = b % 1024, swz = sb ^ (((sb >> 9) & 1) << 5); R = (st >> 1) * 16 + swz / 64; C = (st & 1) * 32 + (swz % 64) / 2; }
__host__ __device__ __forceinline__ int perm32(int rho) { const int n = rho >> 4, i = rho & 15; return 8 * (i >> 2) + 4 * n + (i & 3); }

struct Unit { int pm, pn; };
struct Gemm { const bf16_t* A; const bf16_t* Bt; int M, N, K; };

struct StaticOrder {
    int nM, nN, nwg, G, c;
    __host__ __device__ void init(int M, int N, int G_, int c_) { nM = M / BM; nN = N / BM; nwg = nM * nN; G = G_; c = c_; }
    __host__ __device__ bool next(int i, Unit& u) const {
        const long L = (long)i * G + c; if (L >= nwg) return false;
        int wgid = (int)L; { const int q = nwg / NXCD, r = nwg % NXCD, xcd = wgid % NXCD, off = wgid / NXCD; wgid = (xcd < r ? xcd * (q + 1) : r * (q + 1) + (xcd - r) * q) + off; }
        const int nig = WGM * nN, gid = wgid / nig, fm = gid * WGM, gsz = (nM - fm) < WGM ? (nM - fm) : WGM;
        u.pm = fm + ((wgid % nig) % gsz); u.pn = (wgid % nig) / gsz; return true;
    }
    __device__ __forceinline__ void a_ready(const Unit&) const {}
    __device__ __forceinline__ void done(const Unit&) const {}
};

__device__ __forceinline__ unsigned cvt_pk_bf16(float lo, float hi) { unsigned r; asm volatile("v_cvt_pk_bf16_f32 %0, %1, %2" : "=v"(r) : "v"(lo), "v"(hi)); return r; }
typedef float f32x2 __attribute__((ext_vector_type(2)));
typedef unsigned u32x4e __attribute__((ext_vector_type(4)));
__device__ __forceinline__ u32x4 pack8bf(const f32x4 a, const f32x4 b) { u32x4 w; w.x = cvt_pk_bf16(a[0], a[1]); w.y = cvt_pk_bf16(a[2], a[3]); w.z = cvt_pk_bf16(b[0], b[1]); w.w = cvt_pk_bf16(b[2], b[3]); return w; }
struct EpiPlain {
    static constexpr bool PERM = true, AFTER_DRAIN = false;
    bf16_t* O; int ldc;
    __device__ __forceinline__ void operator()(const f32x4 (&acc)[2][2][4][2], const Unit& u, int wr, int wc, int fr, int fq) const {
        const int row0 = u.pm * BM + wr * 64 + fr, col0 = u.pn * BM + wc * 32 + 8 * fq;
#pragma unroll
        for (int ai = 0; ai < 2; ++ai)
#pragma unroll
            for (int m = 0; m < 4; ++m) { bf16_t* rowp = O + (size_t)(row0 + ai * HALF + m * 16) * ldc + col0;
#pragma unroll
                for (int bj = 0; bj < 2; ++bj) *(u32x4*)(rowp + bj * HALF) = pack8bf(acc[ai][bj][m][0], acc[ai][bj][m][1]); }
    }
};
struct EpiSwiglu {
    static constexpr bool PERM = true, AFTER_DRAIN = false;
    bf16_t* O; int ldc;
    __device__ __forceinline__ void operator()(const f32x4 (&acc)[2][2][4][2], const Unit& u, int wr, int wc, int fr, int fq) const {
        const int row0 = u.pm * BM + wr * 64 + fr, col0 = u.pn * HALF + wc * 32 + 8 * fq;
#pragma unroll
        for (int ai = 0; ai < 2; ++ai)
#pragma unroll
            for (int m = 0; m < 4; ++m) { f32x4 h[2];
#pragma unroll
                for (int n = 0; n < 2; ++n) { const f32x4 g = acc[ai][0][m][n], up = acc[ai][1][m][n];
#pragma unroll
                    for (int i = 0; i < 4; ++i) { const float e = __builtin_amdgcn_exp2f(g[i] * -1.4426950408889634f); h[n][i] = g[i] * up[i] * __builtin_amdgcn_rcpf(1.0f + e); } }
                __builtin_nontemporal_store(pack8bf(h[0], h[1]), (u32x4*)(O + (size_t)(row0 + ai * HALF + m * 16) * ldc + col0)); }
    }
};
struct EpiProj {
    static constexpr bool PERM = true, AFTER_DRAIN = false;
    bf16_t* O; const float* cs; const float* sn; float qscale;
    __device__ __forceinline__ void operator()(const f32x4 (&acc)[2][2][4][2], const Unit& u, int wr, int wc, int fr, int fq) const {
        const int pn = u.pn, row0 = u.pm * BM + wr * 64 + fr; constexpr int LD = 2304;
        const bool ropet = (pn < 4) || pn == 6 || pn == 7 || (pn == 8 && wc < 2);
        if (ropet) {
            const float sc = (pn < 2 || pn == 6 || pn == 7) ? qscale : 1.f;
            const int cbase = (pn == 8 ? 2048 : pn * 256) + 64 * wc + 8 * fq;
            const int pos0 = row0 & 2047;
            f32x4 bc0 = *(const f32x4*)(cs + pos0 * 32 + 8 * fq), bc1 = *(const f32x4*)(cs + pos0 * 32 + 8 * fq + 4), bs0 = *(const f32x4*)(sn + pos0 * 32 + 8 * fq), bs1 = *(const f32x4*)(sn + pos0 * 32 + 8 * fq + 4);
            const f32x4 ca0 = *(const f32x4*)(cs + 16 * 32 + 8 * fq), ca1 = *(const f32x4*)(cs + 16 * 32 + 8 * fq + 4), sa0 = *(const f32x4*)(sn + 16 * 32 + 8 * fq), sa1 = *(const f32x4*)(sn + 16 * 32 + 8 * fq + 4);
            const f32x4 cb0 = *(const f32x4*)(cs + 128 * 32 + 8 * fq), cb1 = *(const f32x4*)(cs + 128 * 32 + 8 * fq + 4), sb0 = *(const f32x4*)(sn + 128 * 32 + 8 * fq), sb1 = *(const f32x4*)(sn + 128 * 32 + 8 * fq + 4);
#pragma unroll
            for (int ai = 0; ai < 2; ++ai) { f32x4 c0 = bc0, c1 = bc1, s0 = bs0, s1 = bs1;
#pragma unroll
                for (int m = 0; m < 4; ++m) { const int row = row0 + ai * HALF + m * 16;
                    const f32x4 x1a = acc[ai][0][m][0], x1b = acc[ai][0][m][1], x2a = acc[ai][1][m][0], x2b = acc[ai][1][m][1];
                    const f32x4 o1a = (x1a * c0 - x2a * s0) * sc, o1b = (x1b * c1 - x2b * s1) * sc, o2a = (x2a * c0 + x1a * s0) * sc, o2b = (x2b * c1 + x1b * s1) * sc;
                    bf16_t* rowp = O + (size_t)row * LD + cbase;
                    *(u32x4*)(rowp) = pack8bf(o1a, o1b); *(u32x4*)(rowp + 32) = pack8bf(o2a, o2b);
                    if (m < 3) { const f32x4 n0 = c0 * ca0 - s0 * sa0, n1 = c1 * ca1 - s1 * sa1; s0 = s0 * ca0 + c0 * sa0; s1 = s1 * ca1 + c1 * sa1; c0 = n0; c1 = n1; } }
                if (ai == 0) { const f32x4 n0 = bc0 * cb0 - bs0 * sb0, n1 = bc1 * cb1 - bs1 * sb1; bs0 = bs0 * cb0 + bc0 * sb0; bs1 = bs1 * cb1 + bc1 * sb1; bc0 = n0; bc1 = n1; } }
        } else {
            const int c0 = (pn == 8) ? (2176 - 64 + 32 * wc + 8 * fq) : (pn * 256 + 32 * wc + 8 * fq), cstep = (pn == 8) ? 64 : HALF;
#pragma unroll
            for (int ai = 0; ai < 2; ++ai)
#pragma unroll
                for (int m = 0; m < 4; ++m) { bf16_t* rowp = O + (size_t)(row0 + ai * HALF + m * 16) * LD + c0;
#pragma unroll
                    for (int bj = 0; bj < 2; ++bj) *(u32x4*)(rowp + bj * cstep) = pack8bf(acc[ai][bj][m][0], acc[ai][bj][m][1]); }
        }
    }
};
template <class Epi, class Sched, bool ALIGN_EPI = false, bool SP2 = false>
__device__ __forceinline__ void gemm_phase(PG8_LAS unsigned char* lds, const Gemm g, const Sched& S, const Epi& E) {
    int tid_ = threadIdx.x; asm volatile("" : "+v"(tid_));
    const int tid = tid_, wid = __builtin_amdgcn_readfirstlane(tid >> 6), lane = tid & 63, wr = wid >> 2, wc = wid & 3, fr = lane & 15, fq = lane >> 4;
    const int K = g.K, nt = K / BK;
    unsigned voffA[2], voffB[2];
#pragma unroll
    for (int i = 0; i < 2; ++i) { int R, C; stage_rc(tid * 16 + i * 8192, R, C); const int Rb = Epi::PERM ? ((R & ~31) + perm32(R & 31)) : R;
        voffA[i] = (unsigned)(R * K + C) * 2u; voffB[i] = (unsigned)(Rb * K + C) * 2u; }
    const size_t kstep = (size_t)(BK * 2);
    const size_t hstep = (size_t)HALF * K * 2;
    const size_t tstep = 2 * hstep;
    const unsigned ldsw = (unsigned)wid * 1024u;
    const int aoff = lds_byte(wr * 64 + fr, fq * 8), boff = lds_byte(wc * 32 + fr, fq * 8);
#define PG8_SA(b, h) (((b) * 2 + (h)) * HTB)
#define PG8_SB(b, h) ((4 + (b) * 2 + (h)) * HTB)
#define PG8_STAGE(bufoff, gbase, voff) do { _Pragma("unroll") for (int _i = 0; _i < 2; ++_i) \
        __builtin_amdgcn_global_load_lds((const unsigned*)((const char*)(gbase) + (voff)[_i]), (PG8_LAS unsigned*)(lds + (bufoff) + ldsw + _i * 8192), 16, 0, 0); } while (0)
#define PG8_LDA(dst, b, h) do { _Pragma("unroll") for (int m = 0; m < 4; ++m) _Pragma("unroll") for (int k = 0; k < 2; ++k) dst[m][k] = *(const PG8_LAS bf16x8*)(lds + PG8_SA(b, h) + aoff + m * 2048 + k * 1024); } while (0)
#define PG8_LDB(dst, b, h) do { _Pragma("unroll") for (int n = 0; n < 2; ++n) _Pragma("unroll") for (int k = 0; k < 2; ++k) dst[n][k] = *(const PG8_LAS bf16x8*)(lds + PG8_SB(b, h) + boff + n * 2048 + k * 1024); } while (0)
#define PG8_MMA(ai, bj, At, Bt) do { __builtin_amdgcn_s_setprio(1); _Pragma("unroll") for (int m = 0; m < 4; ++m) _Pragma("unroll") for (int n = 0; n < 2; ++n) _Pragma("unroll") for (int k = 0; k < 2; ++k) \
        acc[ai][bj][m][n] = __builtin_amdgcn_mfma_f32_16x16x32_bf16(Bt[n][k], At[m][k], acc[ai][bj][m][n], 0, 0, 0); __builtin_amdgcn_s_setprio(0); } while (0)
#define PG8_WAIT_V(n) asm volatile("s_waitcnt vmcnt(" #n ")" ::: "memory")
#define PG8_WAIT_L(n) asm volatile("s_waitcnt lgkmcnt(" #n ")" ::: "memory")
#define PG8_BAR __builtin_amdgcn_s_barrier()
#define PG8_SCHED __builtin_amdgcn_sched_barrier(0)
    Unit cur, nxt; int ui = 0;
    if (!S.next(0, cur)) return;
    f32x4 acc[2][2][4][2];
#pragma unroll
    for (int a = 0; a < 2; ++a)
#pragma unroll
        for (int b = 0; b < 2; ++b)
#pragma unroll
            for (int m = 0; m < 4; ++m)
#pragma unroll
                for (int n = 0; n < 2; ++n) acc[a][b][m][n] = (f32x4){0.f, 0.f, 0.f, 0.f};
    bf16x8 At[4][2], B0[2][2], B1[2][2];
    const char* cA = (const char*)g.A + (size_t)cur.pm * tstep; const char* cB = (const char*)g.Bt + (size_t)cur.pn * tstep;
    S.a_ready(cur);
    if constexpr (SP2) {
        PG8_STAGE(PG8_SB(0, 0), cB, voffB); PG8_STAGE(PG8_SB(0, 1), cB + hstep, voffB); PG8_STAGE(PG8_SA(0, 0), cA, voffA); PG8_STAGE(PG8_SA(0, 1), cA + hstep, voffA);
        if (wr == 1) PG8_BAR;
        PG8_WAIT_V(2); PG8_BAR;
        PG8_STAGE(PG8_SB(1, 0), cB + kstep, voffB); PG8_STAGE(PG8_SA(1, 0), cA + kstep, voffA); PG8_STAGE(PG8_SB(1, 1), cB + hstep + kstep, voffB);
        PG8_WAIT_V(6); PG8_BAR;
    } else {
        PG8_STAGE(PG8_SB(0, 0), cB, voffB); PG8_STAGE(PG8_SA(0, 0), cA, voffA); PG8_STAGE(PG8_SB(0, 1), cB + hstep, voffB); PG8_STAGE(PG8_SA(0, 1), cA + hstep, voffA);
        if (wr == 1) PG8_BAR;
        PG8_WAIT_V(4); PG8_BAR;
        PG8_STAGE(PG8_SB(1, 0), cB + kstep, voffB); PG8_STAGE(PG8_SA(1, 0), cA + kstep, voffA); PG8_STAGE(PG8_SB(1, 1), cB + hstep + kstep, voffB);
        PG8_WAIT_V(6); PG8_BAR;
    }
    for (;;) {
        const bool has_next = S.next(ui + 1, nxt);
        const char* nA = has_next ? (const char*)g.A + (size_t)nxt.pm * tstep : cA; const char* nB = has_next ? (const char*)g.Bt + (size_t)nxt.pn * tstep : cB;
        for (int t = 0; t < nt; t += 2) {
            const bool last = (t == nt - 2);
            const char* a1 = cA + (size_t)(t + 1) * kstep;
            const char* a2 = last ? nA : cA + (size_t)(t + 2) * kstep; const char* b2 = last ? nB : cB + (size_t)(t + 2) * kstep;
            const char* a3 = a2 + kstep; const char* b3 = b2 + kstep;
            if (last && has_next) S.a_ready(nxt);
            if constexpr (SP2) {
            PG8_LDB(B0, 0, 0); PG8_LDB(B1, 0, 1); PG8_SCHED; PG8_LDA(At, 0, 0); PG8_STAGE(PG8_SA(1, 1), a1 + hstep, voffA);
            PG8_WAIT_V(8); PG8_WAIT_L(0); PG8_BAR; PG8_MMA(0, 0, At, B0); PG8_MMA(0, 1, At, B1); PG8_BAR; PG8_SCHED;
            PG8_LDA(At, 0, 1); PG8_STAGE(PG8_SB(0, 0), b2, voffB); PG8_STAGE(PG8_SB(0, 1), b2 + hstep, voffB); PG8_STAGE(PG8_SA(0, 0), a2, voffA);
            PG8_WAIT_V(8); PG8_WAIT_L(0); PG8_BAR; PG8_MMA(1, 0, At, B0); PG8_MMA(1, 1, At, B1); PG8_BAR; PG8_SCHED;
            PG8_LDB(B0, 1, 0); PG8_LDB(B1, 1, 1); PG8_SCHED; PG8_LDA(At, 1, 0); PG8_STAGE(PG8_SA(0, 1), a2 + hstep, voffA);
            PG8_WAIT_V(8); PG8_WAIT_L(0); PG8_BAR; PG8_MMA(0, 0, At, B0); PG8_MMA(0, 1, At, B1); PG8_BAR; PG8_SCHED;
            PG8_LDA(At, 1, 1); PG8_STAGE(PG8_SB(1, 0), b3, voffB); PG8_STAGE(PG8_SB(1, 1), b3 + hstep, voffB); PG8_STAGE(PG8_SA(1, 0), a3, voffA);
            PG8_WAIT_V(8); PG8_WAIT_L(0); PG8_BAR; PG8_MMA(1, 0, At, B0); PG8_MMA(1, 1, At, B1); PG8_BAR; PG8_SCHED;
            } else {
            PG8_LDB(B0, 0, 0); PG8_SCHED; PG8_LDA(At, 0, 0); PG8_STAGE(PG8_SA(1, 1), a1 + hstep, voffA);
            PG8_WAIT_L(8); PG8_BAR; PG8_WAIT_L(0); PG8_MMA(0, 0, At, B0); PG8_BAR; PG8_SCHED;
            PG8_LDB(B1, 0, 1); PG8_STAGE(PG8_SB(0, 0), b2, voffB);
            PG8_BAR; PG8_WAIT_L(0); PG8_MMA(0, 1, At, B1); PG8_BAR;
            PG8_LDA(At, 0, 1); PG8_STAGE(PG8_SA(0, 0), a2, voffA);
            PG8_BAR; PG8_WAIT_L(0); PG8_MMA(1, 0, At, B0); PG8_BAR; PG8_SCHED;
            PG8_STAGE(PG8_SB(0, 1), b2 + hstep, voffB);
            PG8_WAIT_V(6); PG8_BAR; PG8_MMA(1, 1, At, B1); PG8_BAR;
            PG8_LDB(B0, 1, 0); PG8_SCHED; PG8_LDA(At, 1, 0); PG8_STAGE(PG8_SA(0, 1), a2 + hstep, voffA);
            PG8_WAIT_L(8); PG8_BAR; PG8_WAIT_L(0); PG8_MMA(0, 0, At, B0); PG8_BAR; PG8_SCHED;
            PG8_LDB(B1, 1, 1); PG8_STAGE(PG8_SB(1, 0), b3, voffB);
            PG8_BAR; PG8_WAIT_L(0); PG8_MMA(0, 1, At, B1); PG8_BAR;
            PG8_LDA(At, 1, 1); PG8_STAGE(PG8_SA(1, 0), a3, voffA);
            PG8_BAR; PG8_WAIT_L(0); PG8_MMA(1, 0, At, B0); PG8_BAR; PG8_SCHED;
            PG8_STAGE(PG8_SB(1, 1), b3 + hstep, voffB);
            PG8_WAIT_V(6); PG8_BAR; PG8_MMA(1, 1, At, B1); PG8_BAR;
            }
        }
        if constexpr (ALIGN_EPI) { if (wr == 0) PG8_BAR; }
        if constexpr (!Epi::AFTER_DRAIN) { E(acc, cur, wr, wc, fr, fq); S.done(cur); }
        if (!has_next) break;
#pragma unroll
        for (int a = 0; a < 2; ++a)
#pragma unroll
            for (int b = 0; b < 2; ++b)
#pragma unroll
                for (int m = 0; m < 4; ++m)
#pragma unroll
                    for (int n = 0; n < 2; ++n) acc[a][b][m][n] = (f32x4){0.f, 0.f, 0.f, 0.f};
        cur = nxt; cA = nA; cB = nB; ++ui;
        if constexpr (ALIGN_EPI) { if (wr == 1) PG8_BAR; }
    }
    PG8_WAIT_V(0);
    if constexpr (!ALIGN_EPI) { if (wr == 0) PG8_BAR; }
    PG8_BAR;
    if constexpr (Epi::AFTER_DRAIN) { E.fused(acc, cur, wr, wc, fr, fq, lds, wid, lane); S.done(cur); }
#undef PG8_SA
#undef PG8_SB
#undef PG8_STAGE
#undef PG8_LDA
#undef PG8_LDB
#undef PG8_MMA
#undef PG8_WAIT_V
#undef PG8_WAIT_L
#undef PG8_BAR
#undef PG8_SCHED
}
}

constexpr int BATCH = 16, SEQ = 2048, DM = 1024, M_TOK = BATCH * SEQ, DFF = 2816, NPROJ = 2304, DEPTH = 2;
constexpr float EPS = 1e-6f;
constexpr float C2 = 0.125f * 1.4426950408889634f;

namespace att {
typedef short bf16x8 __attribute__((ext_vector_type(8)));
typedef short s16x4 __attribute__((ext_vector_type(4)));
typedef float f32x16 __attribute__((ext_vector_type(16)));
typedef float f32x4 __attribute__((ext_vector_type(4)));
typedef unsigned u32x4 __attribute__((ext_vector_type(4)));
typedef unsigned short bf16_t;
constexpr int LDQ = NPROJ;
constexpr int SHM_K = 8192, SHM_V = 16384;
constexpr int OFF_K = 0, OFF_V = 2 * SHM_K, OFF_WS = OFF_V + 3 * SHM_V, OFF_O1 = OFF_WS + 8 * 256, LDS_END = OFF_O1 + 8 * 8192;
constexpr float THR2 = 10.f;
#define SBAR() __builtin_amdgcn_sched_barrier(0)
#define KSWZ64(row, colB) ((row) * 128 + ((colB) ^ ((((row) >> 1) & 7) << 4)))
template <int NCB> __device__ __forceinline__ int v_st(int k, int c) { const int kk = (k & ~0xC) | ((k & 4) << 1) | ((k & 8) >> 1); return ((kk >> 3) * NCB + (c >> 5)) * 512 + ((kk & 7) * 32 + (c & 31)) * 2; }
__device__ __forceinline__ int v_rd_base(int lane) { return ((lane & 3) << 3) | (((lane >> 2) & 3) << 6) | (((lane >> 4) & 1) << 5) | (((lane >> 5) & 1) << 8); }
__device__ __forceinline__ int crow(int r, int hi) { return (r & 3) + 8 * (r >> 2) + 4 * hi; }
typedef float f32x2_t __attribute__((ext_vector_type(2))); typedef __bf16 bf16x2_t __attribute__((ext_vector_type(2)));
__device__ __forceinline__ unsigned cvtpk(float lo, float hi) { const f32x2_t v = {lo, hi}; const bf16x2_t b = __builtin_convertvector(v, bf16x2_t); return __builtin_bit_cast(unsigned, b); }
__device__ __forceinline__ void mask_tile(f32x16& p0, f32x16& p1, int dq, unsigned W) {
    const float NEG = -__builtin_inff();
#pragma unroll
    for (int r = 0; r < 16; ++r) { const int c = (r & 3) + 8 * (r >> 2);
        if ((unsigned)(dq - c) >= W) p0[r] = NEG;
        if ((unsigned)(dq - c - 32) >= W) p1[r] = NEG; }
}
__device__ __forceinline__ void qkt(f32x16& p0, f32x16& p1, const char* Kt, int r32, int hi, const bf16x8* qr, const f32x16& negm) {
    bf16x8 kf[8];
#pragma unroll
    for (int d0 = 0; d0 < 4; ++d0) { const char* a = Kt + KSWZ64(r32, d0 * 32 + hi * 16);
        kf[2 * d0] = *reinterpret_cast<const bf16x8*>(a); kf[2 * d0 + 1] = *reinterpret_cast<const bf16x8*>(a + 32 * 128); }
    SBAR();
    __builtin_amdgcn_s_setprio(1);
    p0 = __builtin_amdgcn_mfma_f32_32x32x16_bf16(kf[0], qr[0], negm, 0, 0, 0);
    p1 = __builtin_amdgcn_mfma_f32_32x32x16_bf16(kf[1], qr[0], negm, 0, 0, 0);
#pragma unroll
    for (int d0 = 1; d0 < 4; ++d0) {
        p0 = __builtin_amdgcn_mfma_f32_32x32x16_bf16(kf[2 * d0], qr[d0], p0, 0, 0, 0);
        p1 = __builtin_amdgcn_mfma_f32_32x32x16_bf16(kf[2 * d0 + 1], qr[d0], p1, 0, 0, 0); }
    __builtin_amdgcn_s_setprio(0);
}
__device__ __forceinline__ void softmax_tile(f32x16& p0, f32x16& p1, float& m_reg, float& l_reg, float& alpha, f32x16& negm, bool first, bf16x8& pa0, bf16x8& pa1, bf16x8& pa2, bf16x8& pa3) {
    float pmax = p0[0];
#pragma unroll
    for (int r = 1; r < 16; ++r) pmax = fmaxf(pmax, p0[r]);
#pragma unroll
    for (int r = 0; r < 16; ++r) pmax = fmaxf(pmax, p1[r]);
    { auto rr = __builtin_amdgcn_permlane32_swap(__float_as_uint(pmax), __float_as_uint(pmax), false, false); pmax = fmaxf(__uint_as_float(rr[0]), __uint_as_float(rr[1])); }
    if (!first && __all(pmax <= THR2)) { alpha = 1.f; }
    else {
        const float dl = first ? (pmax > -__builtin_inff() ? pmax : 0.f) : fmaxf(pmax, 0.f);
        alpha = first ? 1.f : __builtin_amdgcn_exp2f(-dl); m_reg += dl;
#pragma unroll
        for (int r = 0; r < 16; ++r) { p0[r] -= dl; p1[r] -= dl; }
#pragma unroll
        for (int r = 0; r < 16; ++r) negm[r] = -m_reg;
    }
#pragma unroll
    for (int r = 0; r < 16; ++r) { p0[r] = __builtin_amdgcn_exp2f(p0[r]); p1[r] = __builtin_amdgcn_exp2f(p1[r]); }
    float ps = 0.f;
#pragma unroll
    for (int r = 0; r < 16; ++r) ps += p0[r] + p1[r];
    { auto rr = __builtin_amdgcn_permlane32_swap(__float_as_uint(ps), __float_as_uint(ps), false, false); ps = __uint_as_float(rr[0]) + __uint_as_float(rr[1]); }
    l_reg = l_reg * alpha + ps;
#define PK4(P, B_, OUT) do { unsigned a0 = cvtpk(P[B_+0], P[B_+1]), a1 = cvtpk(P[B_+2], P[B_+3]); unsigned b0 = cvtpk(P[B_+4], P[B_+5]), b1 = cvtpk(P[B_+6], P[B_+7]); \
        auto r0 = __builtin_amdgcn_permlane32_swap(a0, b0, false, false); auto r1 = __builtin_amdgcn_permlane32_swap(a1, b1, false, false); \
        u32x4 w = {r0[0], r1[0], r0[1], r1[1]}; OUT = *reinterpret_cast<bf16x8*>(&w); } while (0)
    PK4(p0, 0, pa0); PK4(p0, 8, pa1); PK4(p1, 0, pa2); PK4(p1, 8, pa3);
#undef PK4
}
template <int NCB> __device__ __forceinline__ void pv_tile(f32x16* o, int vb, const bf16x8 (&pa)[4]) {
#define TRRD(dst, off) asm volatile("ds_read_b64_tr_b16 %0, %1 offset:%2" : "=&v"(dst) : "v"(vb), "i"(off) : "memory")
#define LWAIT(n) asm volatile("s_waitcnt lgkmcnt(" #n ")" ::: "memory")
    constexpr int G = NCB * 512;
#pragma unroll
    for (int dp = 0; dp < NCB; dp += 2) { s16x4 l[4][2], h[4][2];
#pragma unroll
        for (int ks = 0; ks < 4; ++ks)
#pragma unroll
            for (int e = 0; e < 2; ++e) { TRRD(l[ks][e], (dp + e) * 512 + (2 * ks) * G); TRRD(h[ks][e], (dp + e) * 512 + (2 * ks + 1) * G); }
#define PVM(ks) do { SBAR(); _Pragma("unroll") for (int e = 0; e < 2; ++e) \
            o[dp + e] = __builtin_amdgcn_mfma_f32_32x32x16_bf16(pa[ks], (bf16x8){l[ks][e][0], l[ks][e][1], l[ks][e][2], l[ks][e][3], h[ks][e][0], h[ks][e][1], h[ks][e][2], h[ks][e][3]}, o[dp + e], 0, 0, 0); SBAR(); } while (0)
        LWAIT(12); PVM(0); LWAIT(8); PVM(1); LWAIT(4); PVM(2); LWAIT(0); PVM(3);
#undef PVM
    }
#undef TRRD
#undef LWAIT
}
struct Pre { bf16x8 qr[4]; bf16x8 sk, sv0, sv1; };
template <int DV> __device__ __forceinline__ void attn_core(const bf16_t* Qw, const bf16_t* Kh, const bf16_t* Vh, int qlo, int t_lo, int t_hi, int W, char* lds,
                                                            f32x16 (&o)[DV / 32], float& m_reg, float& l_reg, Pre& pre, bool have_pre, const bf16_t* nQw, const bf16_t* nKh, const bf16_t* nVh, int n_tlo, bool has_next) {
    constexpr int NCB = DV / 32;
    int tid_ = threadIdx.x; asm volatile("" : "+v"(tid_));
    const int tid = tid_, wid = __builtin_amdgcn_readfirstlane(tid >> 6), lane = tid & 63, r32 = lane & 31, hi = lane >> 5;
    char* K_lds = lds + OFF_K; char* V_lds = lds + OFF_V; float* al_l = (float*)(lds + OFF_WS) + wid * 64;
    bf16x8 qr[4];
    if (have_pre) {
#pragma unroll
        for (int d0 = 0; d0 < 4; ++d0) qr[d0] = pre.qr[d0]; }
    else {
#pragma unroll
        for (int d0 = 0; d0 < 4; ++d0) qr[d0] = *reinterpret_cast<const bf16x8*>(Qw + (size_t)r32 * LDQ + d0 * 16 + hi * 8); }
    const int kr = tid >> 3, kc = (tid & 7) * 8, kws = KSWZ64(kr, kc * 2);
    const bf16_t* kg = Kh + (size_t)kr * LDQ + kc;
    int vst0, vst1 = 0; const bf16_t* vg;
    if constexpr (DV == 128) { const int sr = tid >> 4, sc = (tid & 15) * 8; vst0 = v_st<NCB>(sr, sc); vst1 = v_st<NCB>(32 + sr, sc); vg = Vh + (size_t)sr * LDQ + sc; }
    else { const int vr = tid >> 3, vc = (tid & 7) * 8; vst0 = v_st<NCB>(vr, vc); vg = Vh + (size_t)vr * LDQ + vc; }
    const int vb0 = (int)(uintptr_t)V_lds + v_rd_base(lane);
    bf16x8 sk, sv0, sv1 = bf16x8{};
#define SLOAD(t) do { const size_t ro_ = (size_t)(t) * 64 * LDQ; sk = *reinterpret_cast<const bf16x8*>(kg + ro_); sv0 = *reinterpret_cast<const bf16x8*>(vg + ro_); \
        if constexpr (DV == 128) sv1 = *reinterpret_cast<const bf16x8*>(vg + ro_ + (size_t)32 * LDQ); } while (0)
#define SWRITE(kbf, vsl) do { *reinterpret_cast<bf16x8*>(K_lds + (kbf) * SHM_K + kws) = sk; *reinterpret_cast<bf16x8*>(V_lds + (vsl) * SHM_V + vst0) = sv0; \
        if constexpr (DV == 128) *reinterpret_cast<bf16x8*>(V_lds + (vsl) * SHM_V + vst1) = sv1; } while (0)
    if (have_pre) { sk = pre.sk; sv0 = pre.sv0; sv1 = pre.sv1; } else { SLOAD(t_lo); }
    SWRITE(0, 0);
    m_reg = 0.f; l_reg = 0.f; f32x16 negm = f32x16{}; bool first = true;
#pragma unroll
    for (int d = 0; d < NCB; ++d) o[d] = f32x16{};
    __syncthreads();
    const bool grpB = wid >= 4;
    bf16x8 pa[4]; pa[0] = bf16x8{}; pa[1] = bf16x8{}; pa[2] = bf16x8{}; pa[3] = bf16x8{};
    bool pact = false; int kbuf = 0, vs_prev = 2, vs_cur = 0, vs_next = 1;
    for (int t = t_lo; t < t_hi; ++t) {
        const bool more = t + 1 < t_hi;
        if (more) SLOAD(t + 1);
        const int kb = t * 64;
        const bool act = (kb <= qlo + 31) && (kb + 63 >= qlo - W + 1);
        if (grpB && pact) pv_tile<NCB>(o, vb0 + vs_prev * SHM_V, pa);
        if (act) {
            f32x16 p0, p1; float alpha;
            qkt(p0, p1, K_lds + kbuf * SHM_K, r32, hi, qr, negm);
            if (kb + 63 > qlo || kb <= qlo + 31 - W) mask_tile(p0, p1, qlo + r32 - 4 * hi - kb, (unsigned)W);
            softmax_tile(p0, p1, m_reg, l_reg, alpha, negm, first, pa[0], pa[1], pa[2], pa[3]); first = false;
            if (__any(alpha < 1.f)) { if (hi == 0) al_l[r32] = alpha; asm volatile("s_waitcnt lgkmcnt(0)" ::: "memory");
#pragma unroll
                for (int r = 0; r < 16; ++r) { const float f = al_l[crow(r, hi)];
#pragma unroll
                    for (int d = 0; d < NCB; ++d) o[d][r] *= f; } }
            if (!grpB) pv_tile<NCB>(o, vb0 + vs_cur * SHM_V, pa);
        }
        pact = act;
        if (more) SWRITE(kbuf ^ 1, vs_next);
        __syncthreads();
        kbuf ^= 1; vs_prev = vs_cur; vs_cur = vs_next; vs_next = (vs_next == 2) ? 0 : vs_next + 1;
    }
    if (grpB && pact) pv_tile<NCB>(o, vb0 + vs_prev * SHM_V, pa);
    __syncthreads();
    if (has_next) {
#pragma unroll
        for (int d0 = 0; d0 < 4; ++d0) pre.qr[d0] = *reinterpret_cast<const bf16x8*>(nQw + (size_t)r32 * LDQ + d0 * 16 + hi * 8);
        const size_t ro_ = (size_t)n_tlo * 64 * LDQ;
        pre.sk = *reinterpret_cast<const bf16x8*>(nKh + (kg - Kh) + ro_); pre.sv0 = *reinterpret_cast<const bf16x8*>(nVh + (vg - Vh) + ro_);
        if constexpr (DV == 128) pre.sv1 = *reinterpret_cast<const bf16x8*>(nVh + (vg - Vh) + ro_ + (size_t)32 * LDQ); }
#undef SLOAD
#undef SWRITE
}
__device__ __forceinline__ void diff_pair(int b, int h, int s, const bf16_t* PROJ, bf16_t* OB, float lam, float onemli, const float* subg, char* lds) {
    int tid_ = threadIdx.x; asm volatile("" : "+v"(tid_));
    const int tid = tid_, wid = __builtin_amdgcn_readfirstlane(tid >> 6), lane = tid & 63, r32 = lane & 31, hi = lane >> 5;
    const size_t rowb = (size_t)b * SEQ; Pre pre; bool have = false;
    unsigned* o1s = (unsigned*)(lds + OFF_O1) + wid * 2048; float* wsf = (float*)(lds + OFF_WS) + wid * 64;
#pragma unroll 1
    for (int k = 0; k < 4; ++k) { const int mp = k & 1, qb = (k < 2) ? 7 - s : s, q0 = qb * 256, qlo = q0 + wid * 32;
        const int nmp = (k + 1) & 1, nqb = (k + 1 < 2) ? 7 - s : s, nqlo = nqb * 256 + wid * 32; const bool has_next = k < 3;
        const bf16_t* Qw = PROJ + (rowb + qlo) * LDQ + (h * 2 + mp) * 64;
        const bf16_t* Kh = PROJ + rowb * LDQ + 512 + (h * 2 + mp) * 64;
        const bf16_t* Vh = PROJ + rowb * LDQ + 1024 + h * 128;
        f32x16 o[4]; float m_reg, l_reg;
        attn_core<128>(Qw, Kh, Vh, qlo, 0, (q0 + 256) / 64, 1 << 30, lds, o, m_reg, l_reg, pre, have, PROJ + (rowb + nqlo) * LDQ + (h * 2 + nmp) * 64, PROJ + rowb * LDQ + 512 + (h * 2 + nmp) * 64, Vh, 0, has_next);
        have = has_next;
        int lane2 = threadIdx.x & 63; asm volatile("" : "+v"(lane2)); const int lane = lane2, r32 = lane & 31, hi = lane >> 5;
        if (hi == 0) wsf[32 + r32] = l_reg; asm volatile("s_waitcnt lgkmcnt(0)" ::: "memory");
        if (mp == 0) {
#pragma unroll
            for (int r = 0; r < 16; ++r) { const float rl = __builtin_amdgcn_rcpf(wsf[32 + crow(r, hi)]);
                o1s[(r * 2 + 0) * 64 + lane] = cvtpk(o[0][r] * rl, o[1][r] * rl); o1s[(r * 2 + 1) * 64 + lane] = cvtpk(o[2][r] * rl, o[3][r] * rl); }
        } else {
            float g[4];
#pragma unroll
            for (int d = 0; d < 4; ++d) g[d] = subg[d * 32 + r32] * onemli;
            bf16_t* Ow = OB + (rowb + qlo) * DM + h * 128;
#pragma unroll
            for (int r = 0; r < 16; ++r) { const float rl = __builtin_amdgcn_rcpf(wsf[32 + crow(r, hi)]) * lam;
                const unsigned ua = o1s[(r * 2 + 0) * 64 + lane], ub = o1s[(r * 2 + 1) * 64 + lane];
                float v[4]; v[0] = __uint_as_float(ua << 16) - o[0][r] * rl; v[1] = __uint_as_float(ua & 0xffff0000u) - o[1][r] * rl;
                v[2] = __uint_as_float(ub << 16) - o[2][r] * rl; v[3] = __uint_as_float(ub & 0xffff0000u) - o[3][r] * rl;
                float ss = (v[0] * v[0] + v[1] * v[1]) + (v[2] * v[2] + v[3] * v[3]);
#pragma unroll
                for (int x = 1; x < 32; x <<= 1) ss += __shfl_xor(ss, x);
                const float rstd = __builtin_amdgcn_rsqf(ss * (1.f / 128.f) + EPS);
                const int orow = crow(r, hi);
#pragma unroll
                for (int d = 0; d < 4; ++d) { const float val = v[d] * rstd * g[d]; const float vn = __shfl_xor(val, 1);
                    if ((r32 & 1) == 0) __builtin_nontemporal_store(cvtpk(val, vn), (unsigned*)(Ow + (size_t)orow * DM + d * 32 + r32)); } }
        }
    }
}
__device__ __forceinline__ void swa_unit(int b, int kvh, int qblk, const bf16_t* PROJ, bf16_t* OB, const float* sinks, char* lds, Pre& pre, bool have_pre, int nu, bool has_next) {
    const int wid = __builtin_amdgcn_readfirstlane(threadIdx.x >> 6);
    const int j = kvh * 4 + (wid >> 1);
    const size_t rowb = (size_t)b * SEQ; const int q0 = qblk * 64, qlo = q0 + (wid & 1) * 32; float* wsf = (float*)(lds + OFF_WS) + wid * 64;
    const bf16_t* Qw = PROJ + (rowb + qlo) * LDQ + 1536 + 64 * j;
    const bf16_t* Kh = PROJ + rowb * LDQ + 2048 + 64 * kvh;
    const bf16_t* Vh = PROJ + rowb * LDQ + 2176 + 64 * kvh;
    const float sink2 = sinks[j] * 1.4426950408889634f;
    f32x16 o[2]; float m_reg, l_reg;
    const int t_lo = qblk - 2 < 0 ? 0 : qblk - 2;
    const int nb = nu >> 6, nkvh = (nu >> 5) & 1, nqblk = nu & 31, nj = nkvh * 4 + (wid >> 1);
    const size_t nrowb = (size_t)nb * SEQ;
    attn_core<64>(Qw, Kh, Vh, qlo, t_lo, qblk + 1, 128, lds, o, m_reg, l_reg, pre, have_pre, PROJ + (nrowb + nqblk * 64 + (wid & 1) * 32) * LDQ + 1536 + 64 * nj,
                  PROJ + nrowb * LDQ + 2048 + 64 * nkvh, PROJ + nrowb * LDQ + 2176 + 64 * nkvh, nqblk - 2 < 0 ? 0 : nqblk - 2, has_next);
    int lane2 = threadIdx.x & 63; asm volatile("" : "+v"(lane2)); const int r32 = lane2 & 31, hi = lane2 >> 5;
    const float lt = l_reg + __builtin_amdgcn_exp2f(sink2 - m_reg);
    if (hi == 0) wsf[32 + r32] = lt; asm volatile("s_waitcnt lgkmcnt(0)" ::: "memory");
    bf16_t* Ow = OB + (rowb + qlo) * DM + 512 + 64 * j;
#pragma unroll
    for (int r = 0; r < 16; ++r) { const float rl = __builtin_amdgcn_rcpf(wsf[32 + crow(r, hi)]); const int orow = crow(r, hi);
#pragma unroll
        for (int d = 0; d < 2; ++d) { const float val = o[d][r] * rl; const float vn = __shfl_xor(val, 1);
            if ((r32 & 1) == 0) __builtin_nontemporal_store(cvtpk(val, vn), (unsigned*)(Ow + (size_t)orow * DM + d * 32 + r32)); } }
}
#undef SBAR
}

typedef unsigned short bf16;
typedef float f32x4 __attribute__((ext_vector_type(4)));
typedef unsigned v4u __attribute__((ext_vector_type(4)));
typedef unsigned v2u __attribute__((ext_vector_type(2)));
constexpr int NWAVES = 8;
constexpr size_t MiB = 1u << 20;
constexpr size_t WS_CTL = 1536 * 1024, CTL_BYTES = 16384;
constexpr size_t WS_MOD = 0, WS_ROPE = 1 * MiB, WS_W = 2 * MiB, W_LAYER = 23 * MiB;
constexpr size_t WO_IN = 0, WO_OUT = 4608 * 1024, WO_GU = WO_OUT + 2 * MiB, WO_DOWN = WO_GU + 11 * MiB;
constexpr size_t WS_XN = 48 * MiB, WS_PROJ = 112 * MiB, WS_O = 256 * MiB, WS_Y = 320 * MiB, WS_H = 112 * MiB, WS_XH = 384 * MiB, WS_END = 448 * MiB;
static_assert(WO_DOWN + (size_t)DM * DFF * 2 <= W_LAYER && WS_W + 2 * W_LAYER <= WS_XN && WS_H + (size_t)M_TOK * DFF * 2 <= WS_Y, "ws map");
constexpr int LDS_BYTES = 136 * 1024, MISC_OFF = 135 * 1024;
static_assert(att::LDS_END <= MISC_OFF && pg8::STAGE_BYTES <= MISC_OFF && MISC_OFF + 128 <= LDS_BYTES && 3456 * 4 <= (int)CTL_BYTES, "lds map");

__device__ __forceinline__ float wave_sum(float v) {
#pragma unroll
    for (int o = 1; o < 64; o <<= 1) v += __shfl_xor(v, o);
    return v;
}
__device__ __forceinline__ unsigned pk2(float lo, float hi) { unsigned r; asm volatile("v_cvt_pk_bf16_f32 %0, %1, %2" : "=v"(r) : "v"(lo), "v"(hi)); return r; }

__device__ __forceinline__ void transpose_item(const float* W, int K, int N, bf16* WT, int kind, float* scr, int item, int lane) {
    const int nblk = N / 32, kb = item / nblk, nb = item % nblk, k0 = 64 * kb, n0 = 32 * nb;
    int drow0 = n0;
    if (kind == 0) { const int pn = n0 >> 8, c = n0 & 255; int j;
        if (pn == 4 || pn == 5) j = c;
        else if (pn == 8 && c >= 128) { const int vv = c - 128; j = 128 * (vv >> 6) + 64 + (vv & 63); }
        else { j = 128 * ((c >> 5) & 1) + 32 * (c >> 6); }
        drow0 = 256 * pn + j; }
    else if (kind == 2) drow0 = 256 * (n0 >> 7) + (n0 & 127);
    else if (kind == 3) drow0 = 256 * (n0 >> 7) + 128 + (n0 & 127);
    { float wv[32];
#pragma unroll
        for (int i = 0; i < 32; ++i) wv[i] = __builtin_nontemporal_load(W + (size_t)(k0 + 2 * i + (lane >> 5)) * N + n0 + (lane & 31));
#pragma unroll
        for (int i = 0; i < 32; ++i) scr[(2 * i + (lane >> 5)) * 33 + (lane & 31)] = wv[i]; }
    asm volatile("s_waitcnt lgkmcnt(0)" ::: "memory");
    const int c = lane & 7;
#pragma unroll
    for (int j = 0; j < 4; ++j) { const int n = (lane >> 3) + 8 * j; const float* s = scr + (8 * c) * 33 + n;
        v4u o; o.x = pk2(s[0 * 33], s[1 * 33]); o.y = pk2(s[2 * 33], s[3 * 33]); o.z = pk2(s[4 * 33], s[5 * 33]); o.w = pk2(s[6 * 33], s[7 * 33]);
        *(v4u*)(WT + (size_t)(drow0 + n) * K + k0 + 8 * c) = o; }
    asm volatile("s_waitcnt lgkmcnt(0)" ::: "memory");
}


#define LAS __attribute__((address_space(3)))
#define XB_TMO      128
#define XB_XCNT(j)  (256  + 64 * (j))
#define XB_XSUB(j)  (1280 + 64 * (j))
#define XB_XGEN(j)  (2304 + 64 * (j))
#define XB_TOP      3328
#define XB_TOPGEN   3392
#define XCD_BAR_WORDS 3456
#define XB_SPIN_CAP (1u << 18)

__device__ __forceinline__ unsigned xb_ld(unsigned* p)              { return __hip_atomic_load(p, __ATOMIC_RELAXED, __HIP_MEMORY_SCOPE_AGENT); }
__device__ __forceinline__ unsigned xb_add(unsigned* p, unsigned v) { return __hip_atomic_fetch_add(p, v, __ATOMIC_RELAXED, __HIP_MEMORY_SCOPE_AGENT); }
__device__ __forceinline__ unsigned xb_xcc_id() { return (unsigned)__builtin_amdgcn_s_getreg((3 << 11) | 20) & 0xFu; }
#define XB_SPIN(cond, bar) do { unsigned _sp = 0; while (cond) { __builtin_amdgcn_s_sleep(1); \
    if ((++_sp & 255u) == 0u) { if (xb_ld(&(bar)[XB_TMO])) break; if (_sp > XB_SPIN_CAP) { atomicAdd(&(bar)[XB_TMO], 1u); break; } } } } while (0)

struct XcdBarrier {
    unsigned* bar; unsigned x;
    volatile LAS unsigned* st;
};

__device__ __forceinline__ XcdBarrier xcd_barrier_post(unsigned* bar, volatile LAS unsigned* st) {
    XcdBarrier b; b.bar = bar; b.x = xb_xcc_id(); b.st = st;
    if (threadIdx.x == 0) (void)xb_add(&bar[XB_XCNT(b.x)], 1u);
    return b;
}
__device__ __forceinline__ void xcd_barrier_complete(unsigned* bar, unsigned x, unsigned& nloc, unsigned& nx) {
    const unsigned G = gridDim.x * gridDim.y * gridDim.z;
    unsigned sum, cnt, mine, sp = 0u;
    for (;;) {
        sum = 0u; cnt = 0u; mine = 0u;
#pragma unroll
        for (unsigned j = 0; j < 16; ++j) { const unsigned c = xb_ld(&bar[XB_XCNT(j)]); sum += c; cnt += (c > 0u) ? 1u : 0u; mine = (j == x) ? c : mine; }
        if (sum == G) break;
        __builtin_amdgcn_s_sleep(1);
        if ((++sp & 255u) == 0u) { if (xb_ld(&bar[XB_TMO])) break; if (sp > XB_SPIN_CAP) { atomicAdd(&bar[XB_TMO], 1u); break; } }
    }
    nloc = mine > 0u ? mine : 1u; nx = cnt > 0u ? cnt : 1u;
}

__device__ __forceinline__ void xcd_barrier(const XcdBarrier& b) {
    asm volatile("s_waitcnt vmcnt(0)" ::: "memory");
    __syncthreads();
    if (threadIdx.x < 64 && b.st[0] == 0u) {
        unsigned* bar = b.bar; const unsigned G = gridDim.x * gridDim.y * gridDim.z; unsigned c, sum, sp = 0u;
        for (;;) {
            c = (threadIdx.x < 16) ? xb_ld(&bar[XB_XCNT(threadIdx.x)]) : 0u; sum = c;
#pragma unroll
            for (int o = 1; o < 64; o <<= 1) sum += (unsigned)__shfl_xor((int)sum, o);
            if (sum == G) break;
            __builtin_amdgcn_s_sleep(1);
            if ((++sp & 255u) == 0u) { if (xb_ld(&bar[XB_TMO])) break; if (sp > XB_SPIN_CAP) { if (threadIdx.x == 0) atomicAdd(&bar[XB_TMO], 1u); break; } }
        }
        const unsigned cnt = (unsigned)__popcll(__ballot(c > 0u)), mine = (unsigned)__shfl((int)c, (int)b.x);
        if (threadIdx.x == 0) { b.st[0] = mine > 0u ? mine : 1u; b.st[1] = cnt > 0u ? cnt : 1u; }
        asm volatile("s_waitcnt lgkmcnt(0)" ::: "memory");
    }
    if (threadIdx.x == 0) {
        unsigned* bar = b.bar;
        __builtin_amdgcn_s_waitcnt(0);
        unsigned nloc = b.st[0], nx = b.st[1];
        if (nloc == 0u) { xcd_barrier_complete(bar, b.x, nloc, nx); b.st[0] = nloc; b.st[1] = nx; }
        const unsigned old = xb_add(&bar[XB_XSUB(b.x)], 1u);
        const unsigned gen = old / nloc;
        if (old + 1u == (gen + 1u) * nloc) {
            __builtin_amdgcn_fence(__ATOMIC_RELEASE, "agent");
            asm volatile("s_waitcnt vmcnt(0)" ::: "memory");
            const unsigned og = xb_add(&bar[XB_TOP], 1u);
            const unsigned tg = og / nx;
            if (og + 1u == (tg + 1u) * nx) xb_add(&bar[XB_TOPGEN], 1u);
            else XB_SPIN(xb_ld(&bar[XB_TOPGEN]) == tg, bar);
            __builtin_amdgcn_fence(__ATOMIC_ACQUIRE, "agent");
            xb_add(&bar[XB_XGEN(b.x)], 1u);
            asm volatile("s_waitcnt vmcnt(0)" ::: "memory");
        } else {
            XB_SPIN(xb_ld(&bar[XB_TOPGEN]) == gen, bar);
            __builtin_amdgcn_fence(__ATOMIC_ACQUIRE, "agent");
            asm volatile("s_waitcnt vmcnt(0)" ::: "memory");
        }
    }
    __syncthreads();
}

#ifndef REP_P0
#define REP_P0 1
#endif
#ifndef REP_E0
#define REP_E0 1
#endif
#ifndef REP_G1
#define REP_G1 1
#endif
#ifndef REP_ATT
#define REP_ATT 1
#endif
#ifndef REP_G2
#define REP_G2 1
#endif
#ifndef REP_G3
#define REP_G3 1
#endif
#ifndef REP_E1
#define REP_E1 1
#endif
#ifndef REP_SYNC
#define REP_SYNC 0
#endif
#ifndef REP_G4
#define REP_G4 1
#endif
#define REPEAT(n) _Pragma("unroll 1") for (int rep_ = 0; rep_ < (n); ++rep_)
struct Args { const float* in[19]; float* out; unsigned char* ws; int ph_lo, ph_hi; };
enum { I_X = 0, I_C, I_ADAW, I_ADAB, I_GMPRE, I_GMPOST, I_GFPRE, I_GFPOST, I_WIN, I_LQ1, I_LK1, I_LQ2, I_LK2, I_SUBG, I_SINKS, I_WOUT, I_WGATE, I_WUP, I_WDOWN };

typedef _Float16 h16x4 __attribute__((ext_vector_type(4)));
template <bool XIN_H, bool XOUT_H>
__device__ __forceinline__ void ew_phase(const void* xin_, void* xout_, const bf16* Y, const float* gpost, const float* gate, const float* gpre, const float* scv, const float* shv,
                                         bf16* XN, bool has_res, bool has_norm, int gw, int NGW, int lane_) {
    int lane = threadIdx.x & 63; asm volatile("" : "+v"(lane)); (void)lane_;
    constexpr int R = XIN_H ? 8 : 4;
    typedef typename std::conditional<XIN_H, h16x4, f32x4>::type xraw_t;
    for (int r0 = gw * R; r0 < M_TOK; r0 += NGW * R) {
        const int b = r0 >> 11; const size_t ro = (size_t)r0 * DM + 4 * lane, vo = (size_t)b * 6144 + 4 * lane;
        xraw_t xr[R][4]; v2u yw[R][4];
#pragma unroll
        for (int k = 0; k < R; ++k)
#pragma unroll
            for (int j = 0; j < 4; ++j) xr[k][j] = __builtin_nontemporal_load((const xraw_t*)xin_ + (ro + (size_t)k * DM + 256 * j) / 4);
        if (has_res) {
#pragma unroll
            for (int k = 0; k < R; ++k)
#pragma unroll
                for (int j = 0; j < 4; ++j) yw[k][j] = __builtin_nontemporal_load((const v2u*)(Y + ro + (size_t)k * DM + 256 * j));
        }
        f32x4 gp[4], gq[4], sh[4];
        if (has_res) {
#pragma unroll
            for (int j = 0; j < 4; ++j) gp[j] = *(const f32x4*)(gpost + 4 * lane + 256 * j) * *(const f32x4*)(gate + vo + 256 * j); }
        if (has_norm) {
#pragma unroll
            for (int j = 0; j < 4; ++j) { gq[j] = *(const f32x4*)(gpre + 4 * lane + 256 * j) * (*(const f32x4*)(scv + vo + 256 * j) + 1.0f); sh[j] = *(const f32x4*)(shv + vo + 256 * j); } }
#pragma unroll
        for (int k = 0; k < R; ++k) { f32x4 x[4];
#pragma unroll
            for (int j = 0; j < 4; ++j) { if constexpr (XIN_H) x[j] = __builtin_convertvector(xr[k][j], f32x4); else x[j] = xr[k][j]; }
            if (has_res) { f32x4 y[4]; float ss = 0.f;
#pragma unroll
                for (int j = 0; j < 4; ++j) { const v2u w = yw[k][j];
                    y[j] = (f32x4){__uint_as_float(w.x << 16), __uint_as_float(w.x & 0xffff0000u), __uint_as_float(w.y << 16), __uint_as_float(w.y & 0xffff0000u)};
                    ss += (y[j].x * y[j].x + y[j].y * y[j].y) + (y[j].z * y[j].z + y[j].w * y[j].w); }
                const float rstd = __builtin_amdgcn_rsqf(wave_sum(ss) * (1.f / DM) + EPS);
#pragma unroll
                for (int j = 0; j < 4; ++j) { x[j] = x[j] + gp[j] * (y[j] * rstd);
                    if constexpr (XOUT_H) { const h16x4 hx = __builtin_convertvector(x[j], h16x4); __builtin_nontemporal_store(hx, (h16x4*)((_Float16*)xout_ + ro + (size_t)k * DM + 256 * j));
                        x[j] = __builtin_convertvector(hx, f32x4); }
                    else __builtin_nontemporal_store(x[j], (f32x4*)((float*)xout_ + ro + (size_t)k * DM + 256 * j)); } }
            if (has_norm) { float ss = 0.f;
#pragma unroll
                for (int j = 0; j < 4; ++j) ss += (x[j].x * x[j].x + x[j].y * x[j].y) + (x[j].z * x[j].z + x[j].w * x[j].w);
                const float rstd = __builtin_amdgcn_rsqf(wave_sum(ss) * (1.f / DM) + EPS);
#pragma unroll
                for (int j = 0; j < 4; ++j) { const f32x4 hv = (x[j] * rstd) * gq[j] + sh[j]; v2u w; w.x = pk2(hv.x, hv.y); w.y = pk2(hv.z, hv.w); *(v2u*)(XN + ro + (size_t)k * DM + 256 * j) = w; } }
        }
    }
}

constexpr int CONV_I_IN = (DM / 64) * (NPROJ / 32), CONV_I_OUT = (DM / 64) * (DM / 32), CONV_I_G = (DM / 64) * (DFF / 32), CONV_I_D = (DFF / 64) * (DM / 32), CONV_I_LAYER = CONV_I_IN + CONV_I_OUT + 2 * CONV_I_G + CONV_I_D;
constexpr int CONV_URGENT = CONV_I_IN, CONV_TOTAL = DEPTH * CONV_I_LAYER;
__device__ __forceinline__ void convert_weights(const Args& a, unsigned char* ws, float* scr, int it_lo, int it_hi, int iw, int nw, int lane) {
    for (int it = it_lo + iw; it < it_hi; it += nw) {
        const int l = it / CONV_I_LAYER; int r = it % CONV_I_LAYER; unsigned char* wb = ws + WS_W + (size_t)l * W_LAYER;
        if (r < CONV_I_IN) { transpose_item(a.in[I_WIN] + (size_t)l * DM * NPROJ, DM, NPROJ, (bf16*)(wb + WO_IN), 0, scr, r, lane); continue; } r -= CONV_I_IN;
        if (r < CONV_I_OUT) { transpose_item(a.in[I_WOUT] + (size_t)l * DM * DM, DM, DM, (bf16*)(wb + WO_OUT), 1, scr, r, lane); continue; } r -= CONV_I_OUT;
        if (r < CONV_I_G) { transpose_item(a.in[I_WGATE] + (size_t)l * DM * DFF, DM, DFF, (bf16*)(wb + WO_GU), 2, scr, r, lane); continue; } r -= CONV_I_G;
        if (r < CONV_I_G) { transpose_item(a.in[I_WUP] + (size_t)l * DM * DFF, DM, DFF, (bf16*)(wb + WO_GU), 3, scr, r, lane); continue; } r -= CONV_I_G;
        transpose_item(a.in[I_WDOWN] + (size_t)l * DFF * DM, DFF, DM, (bf16*)(wb + WO_DOWN), 1, scr, r, lane);
    }
}

__global__ void __launch_bounds__(NWAVES * 64, 2) fwd_mega(Args a) {
    extern __shared__ __attribute__((aligned(16))) unsigned char lds[];
    cg::grid_group grid = cg::this_grid();
    const int wid = __builtin_amdgcn_readfirstlane(threadIdx.x >> 6);
#define FRESH_TID() int tid = threadIdx.x; asm volatile("" : "+v"(tid)); const int lane = tid & 63; (void)lane
    const int G = gridDim.x, gw = blockIdx.x * NWAVES + wid, NGW = G * NWAVES;
    unsigned char* ws = a.ws;
    float* MOD = (float*)(ws + WS_MOD); float* ROPE_C = (float*)(ws + WS_ROPE); float* ROPE_S = ROPE_C + SEQ * 32;
    bf16* XN = (bf16*)(ws + WS_XN); bf16* PROJ = (bf16*)(ws + WS_PROJ); bf16* OB = (bf16*)(ws + WS_O); bf16* YB = (bf16*)(ws + WS_Y); bf16* HB = (bf16*)(ws + WS_H);
    const int lo = a.ph_lo, hi_ph = a.ph_hi;
    volatile LAS unsigned* MISC = (volatile LAS unsigned*)((LAS unsigned char*)lds + MISC_OFF);
    if (threadIdx.x < 32) MISC[threadIdx.x] = 0u;
    __syncthreads();
    XcdBarrier bar = xcd_barrier_post((unsigned*)(ws + WS_CTL), MISC + 8);
#define IN(k) (lo <= (k) && (k) < hi_ph)
#define SEAM(k) do { if (IN(k) && IN((k) + 1)) xcd_barrier(bar); } while (0)
    if (hi_ph > 4096) grid.sync();

    if (IN(0)) REPEAT(REP_P0) { FRESH_TID();
        for (int u = blockIdx.x; u < 192; u += G) {
            const int l = u / 96, col0 = (u % 96) * 64;
            float* cs = (float*)lds + wid * 2048; float* part = (float*)lds + 16384;
            for (int i = lane; i < 2048; i += 64) { const int b = i >> 7, dd = i & 127; const float cv = a.in[I_C][b * DM + wid * 128 + dd]; cs[i] = cv / (1.0f + __expf(-cv)); }
            asm volatile("s_waitcnt lgkmcnt(0)" ::: "memory");
            float acc[16];
#pragma unroll
            for (int b = 0; b < 16; ++b) acc[b] = 0.f;
            const float* wp = a.in[I_ADAW] + ((size_t)l * DM + wid * 128) * 6144 + col0 + lane;
#pragma unroll 1
            for (int d0 = 0; d0 < 128; d0 += 16) { float w[16];
#pragma unroll
                for (int i = 0; i < 16; ++i) w[i] = __builtin_nontemporal_load(wp + (size_t)(d0 + i) * 6144);
#pragma unroll
                for (int i = 0; i < 16; ++i)
#pragma unroll
                    for (int b = 0; b < 16; ++b) acc[b] += cs[b * 128 + d0 + i] * w[i]; }
#pragma unroll
            for (int b = 0; b < 16; ++b) part[(wid * 16 + b) * 64 + lane] = acc[b];
            __syncthreads();
            for (int idx = tid; idx < 1024; idx += 512) { const int b = idx >> 6, cl = idx & 63; float s = a.in[I_ADAB][l * 6144 + col0 + cl];
#pragma unroll
                for (int w = 0; w < 8; ++w) s += part[(w * 16 + b) * 64 + cl];
                MOD[((size_t)l * 16 + b) * 6144 + col0 + cl] = s; }
            __syncthreads();
        }
    }
    SEAM(0);
    if (IN(1)) REPEAT(REP_E0) { FRESH_TID();
        for (int idx = blockIdx.x * 512 + tid; idx < SEQ * 32; idx += G * 512) {
            const int pos = idx >> 5, i = idx & 31;
            double inv = 1.0; const double rr = 0.74989420933245582730;
            for (int k = 0; k < i; ++k) inv *= rr;
            const float ang = (float)pos * (float)inv;
            const double rev = (double)ang * 0.15915494309189533577, fr = rev - __builtin_rint(rev);
            const double q4 = __builtin_rint(fr * 4.0); const double t = (fr - q4 * 0.25) * 6.28318530717958647692; const int k4 = ((int)q4) & 3;
            const double t2 = t * t;
            const double sn = t * (1.0 + t2 * (-1.0 / 6 + t2 * (1.0 / 120 + t2 * (-1.0 / 5040 + t2 * (1.0 / 362880 + t2 * (-1.0 / 39916800 + t2 * (1.0 / 6227020800.0)))))));
            const double cn = 1.0 + t2 * (-0.5 + t2 * (1.0 / 24 + t2 * (-1.0 / 720 + t2 * (1.0 / 40320 + t2 * (-1.0 / 3628800 + t2 * (1.0 / 479001600.0))))));
            const double S = (k4 == 0) ? sn : (k4 == 1) ? cn : (k4 == 2) ? -sn : -cn, C = (k4 == 0) ? cn : (k4 == 1) ? -sn : (k4 == 2) ? -cn : sn;
            ROPE_C[idx] = (float)C; ROPE_S[idx] = (float)S;
        }
        convert_weights(a, ws, (float*)(lds + wid * 16384), 0, CONV_URGENT, gw, NGW, lane);
        __syncthreads();
        ew_phase<false, false>(a.in[I_X], nullptr, nullptr, nullptr, nullptr, a.in[I_GMPRE], MOD + 1 * DM, MOD + 0 * DM, XN, false, true, gw, NGW, 0);
    }
    SEAM(1);
    REPEAT(REP_SYNC) xcd_barrier(bar);
#pragma unroll 1
    for (int l = 0; l < DEPTH; ++l) {
        const int pb = 2 + 7 * l;
#define FRESH_WS() size_t z_ = 0; asm volatile("" : "+s"(z_)); unsigned char* ws_ = ws + z_; unsigned char* wb = ws_ + WS_W + (size_t)l * W_LAYER; float* modl = (float*)(ws_ + WS_MOD) + (size_t)l * 16 * 6144; \
        bf16* XN = (bf16*)(ws_ + WS_XN); bf16* PROJ = (bf16*)(ws_ + WS_PROJ); bf16* OB = (bf16*)(ws_ + WS_O); bf16* YB = (bf16*)(ws_ + WS_Y); bf16* HB = (bf16*)(ws_ + WS_H); \
        float* ROPE_C = (float*)(ws_ + WS_ROPE); float* ROPE_S = ROPE_C + SEQ * 32; float* MOD = (float*)(ws_ + WS_MOD); float* out_ = a.out + z_; \
        (void)wb; (void)modl; (void)XN; (void)PROJ; (void)OB; (void)YB; (void)HB; (void)ROPE_C; (void)ROPE_S; (void)MOD; (void)out_
        if (IN(pb + 0)) REPEAT(REP_G1) { FRESH_WS(); pg8::Gemm g{XN, (const bf16*)(wb + WO_IN), M_TOK, NPROJ, DM}; pg8::StaticOrder S; S.init(M_TOK, NPROJ, G, (int)blockIdx.x);
            pg8::EpiProj E{PROJ, ROPE_C, ROPE_S, C2};
#ifndef NO_G1
            pg8::gemm_phase<pg8::EpiProj, pg8::StaticOrder, true, true>((PG8_LAS unsigned char*)lds, g, S, E);
#endif
            { const int nu = (M_TOK / 256) * (NPROJ / 256), rem = nu % G;
              if (l == 0 && rem != 0 && (int)blockIdx.x >= rem) { FRESH_TID(); convert_weights(a, ws_, (float*)(lds + wid * 16384), CONV_URGENT, CONV_TOTAL, ((int)blockIdx.x - rem) * NWAVES + wid, (G - rem) * NWAVES, lane); }
              else if (l == 0 && rem == 0) { FRESH_TID(); convert_weights(a, ws_, (float*)(lds + wid * 16384), CONV_URGENT, CONV_TOTAL, gw, NGW, lane); } }
 }
        SEAM(pb + 0);
        if (IN(pb + 1)) REPEAT(REP_ATT) { FRESH_WS(); FRESH_TID();
            const float s1 = wave_sum(a.in[I_LQ1][l * 64 + lane] * a.in[I_LK1][l * 64 + lane]), s2 = wave_sum(a.in[I_LQ2][l * 64 + lane] * a.in[I_LK2][l * 64 + lane]);
            const float lam_init = (l == 0) ? 0.2f : 0.35550906759096924f;
            const float lam = __expf(s1) - __expf(s2) + lam_init;
            for (int u = blockIdx.x; u < 256; u += G) { const int bh = (u & 7) * 8 + (u >> 5), b = bh >> 2, h = bh & 3, s = (u >> 3) & 3;
#ifndef NO_DIFF
                att::diff_pair(b, h, s, PROJ, OB, lam, 1.0f - lam_init, a.in[I_SUBG] + l * 128, (char*)lds);
#endif
 }
            att::Pre spre; bool shave = false;
            for (int u = blockIdx.x; u < 1024; u += G) { const int cmb = (u & 7) * 4 + (u >> 8), b = cmb >> 1, kvh = cmb & 1, qblk = (u >> 3) & 31; const bool snext = u + G < 1024;
#ifndef NO_SWA
                att::swa_unit(b, kvh, qblk, PROJ, OB, a.in[I_SINKS] + l * 8, (char*)lds, spre, false, u, false); (void)shave; (void)snext;
#endif
 }
        }
        SEAM(pb + 1);
        if (IN(pb + 2)) REPEAT(REP_G2) { FRESH_WS(); pg8::Gemm g{OB, (const bf16*)(wb + WO_OUT), M_TOK, DM, DM}; pg8::StaticOrder S; S.init(M_TOK, DM, G, (int)blockIdx.x);
            pg8::EpiPlain E{YB, DM};
            pg8::gemm_phase<pg8::EpiPlain, pg8::StaticOrder, true, true>((PG8_LAS unsigned char*)lds, g, S, E); }
        SEAM(pb + 2);
        if (IN(pb + 3)) REPEAT(l == 0 ? REP_E1 : 1) { FRESH_WS(); _Float16* XH = (_Float16*)(ws_ + WS_XH);
            if (l == 0) ew_phase<false, true>(a.in[I_X] + z_, XH, YB, a.in[I_GMPOST] + l * DM, modl + 2 * DM, a.in[I_GFPRE] + l * DM, modl + 4 * DM, modl + 3 * DM, XN, true, true, gw, NGW, 0);
            else ew_phase<true, true>(XH, XH, YB, a.in[I_GMPOST] + l * DM, modl + 2 * DM, a.in[I_GFPRE] + l * DM, modl + 4 * DM, modl + 3 * DM, XN, true, true, gw, NGW, 0); }
        SEAM(pb + 3);
        if (IN(pb + 4)) REPEAT(REP_G3) { FRESH_WS(); pg8::Gemm g{XN, (const bf16*)(wb + WO_GU), M_TOK, 2 * DFF, DM}; pg8::StaticOrder S; S.init(M_TOK, 2 * DFF, G, (int)blockIdx.x);
            pg8::EpiSwiglu E{HB, DFF};
#ifndef NO_G3
            pg8::gemm_phase<pg8::EpiSwiglu, pg8::StaticOrder, true, true>((PG8_LAS unsigned char*)lds, g, S, E);
#endif
 }
        SEAM(pb + 4);
        if (IN(pb + 5)) REPEAT(REP_G4) { FRESH_WS(); pg8::Gemm g{HB, (const bf16*)(wb + WO_DOWN), M_TOK, DM, DFF}; pg8::StaticOrder S; S.init(M_TOK, DM, G, (int)blockIdx.x);
            pg8::EpiPlain E{YB, DM};
            pg8::gemm_phase<pg8::EpiPlain, pg8::StaticOrder, true, true>((PG8_LAS unsigned char*)lds, g, S, E); }
        SEAM(pb + 5);
        if (IN(pb + 6)) { FRESH_WS(); const int ln = (l + 1 < DEPTH) ? l + 1 : l; float* modn = MOD + (size_t)ln * 16 * 6144;
            _Float16* XH = (_Float16*)(ws_ + WS_XH);
            if (l + 1 < DEPTH) ew_phase<true, true>(XH, XH, YB, a.in[I_GFPOST] + l * DM, modl + 5 * DM, a.in[I_GMPRE] + ln * DM, modn + 1 * DM, modn + 0 * DM, XN, true, true, gw, NGW, 0);
            else ew_phase<true, false>(XH, out_, YB, a.in[I_GFPOST] + l * DM, modl + 5 * DM, a.in[I_GMPRE] + ln * DM, modn + 1 * DM, modn + 0 * DM, XN, true, false, gw, NGW, 0); }
        SEAM(pb + 6);
    }
#undef IN
#undef SEAM
}

constexpr int N_PHASES = 2 + 7 * DEPTH;
#ifndef MK_COOP
#define MK_COOP 1
#endif
extern "C" void kernel_launch(void* const* d_in, const int* in_sizes, int n_in, void* d_out, int out_size, void* d_ws, size_t ws_size, hipStream_t stream) {
    static int grid = 0;
    if (grid == 0) {
        if (n_in != 19 || in_sizes[0] != M_TOK * DM || out_size != M_TOK * DM || ws_size < WS_END) { fprintf(stderr, "kernel_launch: unexpected shapes (n_in %d, ws %zu)\n", n_in, ws_size); grid = -1; return; }
        int dev = 0, cus = 0, per_cu = 0;
        (void)hipGetDevice(&dev); (void)hipDeviceGetAttribute(&cus, hipDeviceAttributeMultiprocessorCount, dev);
        if (hipFuncSetAttribute((const void*)fwd_mega, hipFuncAttributeMaxDynamicSharedMemorySize, LDS_BYTES) != hipSuccess) { fprintf(stderr, "kernel_launch: hipFuncSetAttribute failed\n"); grid = -1; return; }
        if (hipOccupancyMaxActiveBlocksPerMultiprocessor(&per_cu, (const void*)fwd_mega, NWAVES * 64, LDS_BYTES) != hipSuccess || per_cu < 1) { fprintf(stderr, "kernel_launch: occupancy query says %d\n", per_cu); (void)hipGetLastError(); grid = -1; return; }
        grid = cus;
    }
    if (grid < 0) return;
    if (hipMemsetAsync((char*)d_ws + WS_CTL, 0, CTL_BYTES, stream) != hipSuccess) { fprintf(stderr, "kernel_launch: memset failed\n"); return; }
    Args a{};
    for (int i = 0; i < 19; ++i) a.in[i] = (const float*)d_in[i];
    a.out = (float*)d_out; a.ws = (unsigned char*)d_ws;
#if MK_COOP
    a.ph_lo = 0; a.ph_hi = N_PHASES;
    void* args[] = {&a};
    hipError_t e = hipLaunchCooperativeKernel((const void*)fwd_mega, dim3(grid), dim3(NWAVES * 64), args, LDS_BYTES, stream);
    if (e != hipSuccess) fprintf(stderr, "kernel_launch: cooperative launch failed: %s (grid %d)\n", hipGetErrorString(e), grid);
#else
    for (int p = 0; p < N_PHASES; ++p) { a.ph_lo = p; a.ph_hi = p + 1; hipLaunchKernelGGL(fwd_mega, dim3(grid), dim3(NWAVES * 64), LDS_BYTES, stream, a); }
#endif
}
```

```cpp
#include <hip/hip_runtime.h>
#include <hip/hip_cooperative_groups.h>
#include <cstdio>
#include <cstdint>
#include <type_traits>
namespace cg = cooperative_groups;

namespace pg8 {
#define PG8_LAS __attribute__((address_space(3)))
typedef unsigned short bf16_t;
typedef short bf16x8 __attribute__((ext_vector_type(8)));
typedef float f32x4 __attribute__((ext_vector_type(4)));
typedef unsigned u32x4 __attribute__((ext_vector_type(4)));
constexpr int BM = 256, BK = 64, HALF = 128, HTB = HALF * BK * 2  , STAGE_BYTES = 8 * HTB, NXCD = 8, WGM = 8;

__host__ __device__ __forceinline__ int lds_byte(int r, int c) { const int st = (r >> 4) * 2 + (c >> 5), rr = r & 15, cc = c & 31, ob = rr * 64 + cc * 2; return st * 1024 + (ob ^ (((ob >> 9) & 1) << 5)); }
__host__ __device__ __forceinline__ void stage_rc(int b, int& R, int& C) { const int st = b / 1024, sb = b % 1024, swz = sb ^ (((sb >> 9) & 1) << 5); R = (st >> 1) * 16 + swz / 64; C = (st & 1) * 32 + (swz % 64) / 2; }
__host__ __device__ __forceinline__ int perm32(int rho) { const int n = rho >> 4, i = rho & 15; return 8 * (i >> 2) + 4 * n + (i & 3); }

struct Unit { int pm, pn; };
struct Gemm { const bf16_t* A; const bf16_t* Bt; int M, N, K; };

struct StaticOrder {
    int nM, nN, nwg, G, c;
    __host__ __device__ void init(int M, int N, int G_, int c_) { nM = M / BM; nN = N / BM; nwg = nM * nN; G = G_; c = c_; }
    __host__ __device__ bool next(int i, Unit& u) const {
        const long L = (long)i * G + c; if (L >= nwg) return false;
        int wgid = (int)L; { const int q = nwg / NXCD, r = nwg % NXCD, xcd = wgid % NXCD, off = wgid / NXCD; wgid = (xcd < r ? xcd * (q + 1) : r * (q + 1) + (xcd - r) * q) + off; }
        const int nig = WGM * nN, gid = wgid / nig, fm = gid * WGM, gsz = (nM - fm) < WGM ? (nM - fm) : WGM;
        u.pm = fm + ((wgid % nig) % gsz); u.pn = (wgid % nig) / gsz; return true;
    }
    __device__ __forceinline__ void a_ready(const Unit&) const {}
    __device__ __forceinline__ void done(const Unit&) const {}
};

__device__ __forceinline__ unsigned cvt_pk_bf16(float lo, float hi) { unsigned r; asm volatile("v_cvt_pk_bf16_f32 %0, %1, %2" : "=v"(r) : "v"(lo), "v"(hi)); return r; }
typedef float f32x2 __attribute__((ext_vector_type(2)));
typedef unsigned u32x4e __attribute__((ext_vector_type(4)));
__device__ __forceinline__ u32x4 pack8bf(const f32x4 a, const f32x4 b) { u32x4 w; w.x = cvt_pk_bf16(a[0], a[1]); w.y = cvt_pk_bf16(a[2], a[3]); w.z = cvt_pk_bf16(b[0], b[1]); w.w = cvt_pk_bf16(b[2], b[3]); return w; }
struct EpiPlain {
    static constexpr bool PERM = true, AFTER_DRAIN = false;
    bf16_t* O; int ldc;
    __device__ __forceinline__ void operator()(const f32x4 (&acc)[2][2][4][2], const Unit& u, int wr, int wc, int fr, int fq) const {
        const int row0 = u.pm * BM + wr * 64 + fr, col0 = u.pn * BM + wc * 32 + 8 * fq;
#pragma unroll
        for (int ai = 0; ai < 2; ++ai)
#pragma unroll
            for (int m = 0; m < 4; ++m) { bf16_t* rowp = O + (size_t)(row0 + ai * HALF + m * 16) * ldc + col0;
#pragma unroll
                for (int bj = 0; bj < 2; ++bj) *(u32x4*)(rowp + bj * HALF) = pack8bf(acc[ai][bj][m][0], acc[ai][bj][m][1]); }
    }
};
struct EpiSwiglu {
    static constexpr bool PERM = true, AFTER_DRAIN = false;
    bf16_t* O; int ldc;
    __device__ __forceinline__ void operator()(const f32x4 (&acc)[2][2][4][2], const Unit& u, int wr, int wc, int fr, int fq) const {
        const int row0 = u.pm * BM + wr * 64 + fr, col0 = u.pn * HALF + wc * 32 + 8 * fq;
#pragma unroll
        for (int ai = 0; ai < 2; ++ai)
#pragma unroll
            for (int m = 0; m < 4; ++m) { f32x4 h[2];
#pragma unroll
                for (int n = 0; n < 2; ++n) { const f32x4 g = acc[ai][0][m][n], up = acc[ai][1][m][n];
#pragma unroll
                    for (int i = 0; i < 4; ++i) { const float e = __builtin_amdgcn_exp2f(g[i] * -1.4426950408889634f); h[n][i] = g[i] * up[i] * __builtin_amdgcn_rcpf(1.0f + e); } }
                __builtin_nontemporal_store(pack8bf(h[0], h[1]), (u32x4*)(O + (size_t)(row0 + ai * HALF + m * 16) * ldc + col0)); }
    }
};
struct EpiProj {
    static constexpr bool PERM = true, AFTER_DRAIN = false;
    bf16_t* O; const float* cs; const float* sn; float qscale;
    __device__ __forceinline__ void operator()(const f32x4 (&acc)[2][2][4][2], const Unit& u, int wr, int wc, int fr, int fq) const {
        const int pn = u.pn, row0 = u.pm * BM + wr * 64 + fr; constexpr int LD = 2304;
        const bool ropet = (pn < 4) || pn == 6 || pn == 7 || (pn == 8 && wc < 2);
        if (ropet) {
            const float sc = (pn < 2 || pn == 6 || pn == 7) ? qscale : 1.f;
            const int cbase = (pn == 8 ? 2048 : pn * 256) + 64 * wc + 8 * fq;
            const int pos0 = row0 & 2047;
            f32x4 bc0 = *(const f32x4*)(cs + pos0 * 32 + 8 * fq), bc1 = *(const f32x4*)(cs + pos0 * 32 + 8 * fq + 4), bs0 = *(const f32x4*)(sn + pos0 * 32 + 8 * fq), bs1 = *(const f32x4*)(sn + pos0 * 32 + 8 * fq + 4);
            const f32x4 ca0 = *(const f32x4*)(cs + 16 * 32 + 8 * fq), ca1 = *(const f32x4*)(cs + 16 * 32 + 8 * fq + 4), sa0 = *(const f32x4*)(sn + 16 * 32 + 8 * fq), sa1 = *(const f32x4*)(sn + 16 * 32 + 8 * fq + 4);
            const f32x4 cb0 = *(const f32x4*)(cs + 128 * 32 + 8 * fq), cb1 = *(const f32x4*)(cs + 128 * 32 + 8 * fq + 4), sb0 = *(const f32x4*)(sn + 128 * 32 + 8 * fq), sb1 = *(const f32x4*)(sn + 128 * 32 + 8 * fq + 4);
#pragma unroll
            for (int ai = 0; ai < 2; ++ai) { f32x4 c0 = bc0, c1 = bc1, s0 = bs0, s1 = bs1;
#pragma unroll
                for (int m = 0; m < 4; ++m) { const int row = row0 + ai * HALF + m * 16;
                    const f32x4 x1a = acc[ai][0][m][0], x1b = acc[ai][0][m][1], x2a = acc[ai][1][m][0], x2b = acc[ai][1][m][1];
                    const f32x4 o1a = (x1a * c0 - x2a * s0) * sc, o1b = (x1b * c1 - x2b * s1) * sc, o2a = (x2a * c0 + x1a * s0) * sc, o2b = (x2b * c1 + x1b * s1) * sc;
                    bf16_t* rowp = O + (size_t)row * LD + cbase;
                    *(u32x4*)(rowp) = pack8bf(o1a, o1b); *(u32x4*)(rowp + 32) = pack8bf(o2a, o2b);
                    if (m < 3) { const f32x4 n0 = c0 * ca0 - s0 * sa0, n1 = c1 * ca1 - s1 * sa1; s0 = s0 * ca0 + c0 * sa0; s1 = s1 * ca1 + c1 * sa1; c0 = n0; c1 = n1; } }
                if (ai == 0) { const f32x4 n0 = bc0 * cb0 - bs0 * sb0, n1 = bc1 * cb1 - bs1 * sb1; bs0 = bs0 * cb0 + bc0 * sb0; bs1 = bs1 * cb1 + bc1 * sb1; bc0 = n0; bc1 = n1; } }
        } else {
            const int c0 = (pn == 8) ? (2176 - 64 + 32 * wc + 8 * fq) : (pn * 256 + 32 * wc + 8 * fq), cstep = (pn == 8) ? 64 : HALF;
#pragma unroll
            for (int ai = 0; ai < 2; ++ai)
#pragma unroll
                for (int m = 0; m < 4; ++m) { bf16_t* rowp = O + (size_t)(row0 + ai * HALF + m * 16) * LD + c0;
#pragma unroll
                    for (int bj = 0; bj < 2; ++bj) *(u32x4*)(rowp + bj * cstep) = pack8bf(acc[ai][bj][m][0], acc[ai][bj][m][1]); }
        }
    }
};
template <class Epi, class Sched, bool ALIGN_EPI = false, bool SP2 = false>
__device__ __forceinline__ void gemm_phase(PG8_LAS unsigned char* lds, const Gemm g, const Sched& S, const Epi& E) {
    int tid_ = threadIdx.x; asm volatile("" : "+v"(tid_));
    const int tid = tid_, wid = __builtin_amdgcn_readfirstlane(tid >> 6), lane = tid & 63, wr = wid >> 2, wc = wid & 3, fr = lane & 15, fq = lane >> 4;
    const int K = g.K, nt = K / BK;
    unsigned voffA[2], voffB[2];
#pragma unroll
    for (int i = 0; i < 2; ++i) { int R, C; stage_rc(tid * 16 + i * 8192, R, C); const int Rb = Epi::PERM ? ((R & ~31) + perm32(R & 31)) : R;
        voffA[i] = (unsigned)(R * K + C) * 2u; voffB[i] = (unsigned)(Rb * K + C) * 2u; }
    const size_t kstep = (size_t)(BK * 2);
    const size_t hstep = (size_t)HALF * K * 2;
    const size_t tstep = 2 * hstep;
    const unsigned ldsw = (unsigned)wid * 1024u;
    const int aoff = lds_byte(wr * 64 + fr, fq * 8), boff = lds_byte(wc * 32 + fr, fq * 8);
#define PG8_SA(b, h) (((b) * 2 + (h)) * HTB)
#define PG8_SB(b, h) ((4 + (b) * 2 + (h)) * HTB)
#define PG8_STAGE(bufoff, gbase, voff) do { _Pragma("unroll") for (int _i = 0; _i < 2; ++_i) \
        __builtin_amdgcn_global_load_lds((const unsigned*)((const char*)(gbase) + (voff)[_i]), (PG8_LAS unsigned*)(lds + (bufoff) + ldsw + _i * 8192), 16, 0, 0); } while (0)
#define PG8_LDA(dst, b, h) do { _Pragma("unroll") for (int m = 0; m < 4; ++m) _Pragma("unroll") for (int k = 0; k < 2; ++k) dst[m][k] = *(const PG8_LAS bf16x8*)(lds + PG8_SA(b, h) + aoff + m * 2048 + k * 1024); } while (0)
#define PG8_LDB(dst, b, h) do { _Pragma("unroll") for (int n = 0; n < 2; ++n) _Pragma("unroll") for (int k = 0; k < 2; ++k) dst[n][k] = *(const PG8_LAS bf16x8*)(lds + PG8_SB(b, h) + boff + n * 2048 + k * 1024); } while (0)
#define PG8_MMA(ai, bj, At, Bt) do { __builtin_amdgcn_s_setprio(1); _Pragma("unroll") for (int m = 0; m < 4; ++m) _Pragma("unroll") for (int n = 0; n < 2; ++n) _Pragma("unroll") for (int k = 0; k < 2; ++k) \
        acc[ai][bj][m][n] = __builtin_amdgcn_mfma_f32_16x16x32_bf16(Bt[n][k], At[m][k], acc[ai][bj][m][n], 0, 0, 0); __builtin_amdgcn_s_setprio(0); } while (0)
#define PG8_WAIT_V(n) asm volatile("s_waitcnt vmcnt(" #n ")" ::: "memory")
#define PG8_WAIT_L(n) asm volatile("s_waitcnt lgkmcnt(" #n ")" ::: "memory")
#define PG8_BAR __builtin_amdgcn_s_barrier()
#define PG8_SCHED __builtin_amdgcn_sched_barrier(0)
    Unit cur, nxt; int ui = 0;
    if (!S.next(0, cur)) return;
    f32x4 acc[2][2][4][2];
#pragma unroll
    for (int a = 0; a < 2; ++a)
#pragma unroll
        for (int b = 0; b < 2; ++b)
#pragma unroll
            for (int m = 0; m < 4; ++m)
#pragma unroll
                for (int n = 0; n < 2; ++n) acc[a][b][m][n] = (f32x4){0.f, 0.f, 0.f, 0.f};
    bf16x8 At[4][2], B0[2][2], B1[2][2];
    const char* cA = (const char*)g.A + (size_t)cur.pm * tstep; const char* cB = (const char*)g.Bt + (size_t)cur.pn * tstep;
    S.a_ready(cur);
    if constexpr (SP2) {
        PG8_STAGE(PG8_SB(0, 0), cB, voffB); PG8_STAGE(PG8_SB(0, 1), cB + hstep, voffB); PG8_STAGE(PG8_SA(0, 0), cA, voffA); PG8_STAGE(PG8_SA(0, 1), cA + hstep, voffA);
        if (wr == 1) PG8_BAR;
        PG8_WAIT_V(2); PG8_BAR;
        PG8_STAGE(PG8_SB(1, 0), cB + kstep, voffB); PG8_STAGE(PG8_SA(1, 0), cA + kstep, voffA); PG8_STAGE(PG8_SB(1, 1), cB + hstep + kstep, voffB);
        PG8_WAIT_V(6); PG8_BAR;
    } else {
        PG8_STAGE(PG8_SB(0, 0), cB, voffB); PG8_STAGE(PG8_SA(0, 0), cA, voffA); PG8_STAGE(PG8_SB(0, 1), cB + hstep, voffB); PG8_STAGE(PG8_SA(0, 1), cA + hstep, voffA);
        if (wr == 1) PG8_BAR;
        PG8_WAIT_V(4); PG8_BAR;
        PG8_STAGE(PG8_SB(1, 0), cB + kstep, voffB); PG8_STAGE(PG8_SA(1, 0), cA + kstep, voffA); PG8_STAGE(PG8_SB(1, 1), cB + hstep + kstep, voffB);
        PG8_WAIT_V(6); PG8_BAR;
    }
    for (;;) {
        const bool has_next = S.next(ui + 1, nxt);
        const char* nA = has_next ? (const char*)g.A + (size_t)nxt.pm * tstep : cA; const char* nB = has_next ? (const char*)g.Bt + (size_t)nxt.pn * tstep : cB;
        for (int t = 0; t < nt; t += 2) {
            const bool last = (t == nt - 2);
            const char* a1 = cA + (size_t)(t + 1) * kstep;
            const char* a2 = last ? nA : cA + (size_t)(t + 2) * kstep; const char* b2 = last ? nB : cB + (size_t)(t + 2) * kstep;
            const char* a3 = a2 + kstep; const char* b3 = b2 + kstep;
            if (last && has_next) S.a_ready(nxt);
            if constexpr (SP2) {
            PG8_LDB(B0, 0, 0); PG8_LDB(B1, 0, 1); PG8_SCHED; PG8_LDA(At, 0, 0); PG8_STAGE(PG8_SA(1, 1), a1 + hstep, voffA);
            PG8_WAIT_V(8); PG8_WAIT_L(0); PG8_BAR; PG8_MMA(0, 0, At, B0); PG8_MMA(0, 1, At, B1); PG8_BAR; PG8_SCHED;
            PG8_LDA(At, 0, 1); PG8_STAGE(PG8_SB(0, 0), b2, voffB); PG8_STAGE(PG8_SB(0, 1), b2 + hstep, voffB); PG8_STAGE(PG8_SA(0, 0), a2, voffA);
            PG8_WAIT_V(8); PG8_WAIT_L(0); PG8_BAR; PG8_MMA(1, 0, At, B0); PG8_MMA(1, 1, At, B1); PG8_BAR; PG8_SCHED;
            PG8_LDB(B0, 1, 0); PG8_LDB(B1, 1, 1); PG8_SCHED; PG8_LDA(At, 1, 0); PG8_STAGE(PG8_SA(0, 1), a2 + hstep, voffA);
            PG8_WAIT_V(8); PG8_WAIT_L(0); PG8_BAR; PG8_MMA(0, 0, At, B0); PG8_MMA(0, 1, At, B1); PG8_BAR; PG8_SCHED;
            PG8_LDA(At, 1, 1); PG8_STAGE(PG8_SB(1, 0), b3, voffB); PG8_STAGE(PG8_SB(1, 1), b3 + hstep, voffB); PG8_STAGE(PG8_SA(1, 0), a3, voffA);
            PG8_WAIT_V(8); PG8_WAIT_L(0); PG8_BAR; PG8_MMA(1, 0, At, B0); PG8_MMA(1, 1, At, B1); PG8_BAR; PG8_SCHED;
            } else {
            PG8_LDB(B0, 0, 0); PG8_SCHED; PG8_LDA(At, 0, 0); PG8_STAGE(PG8_SA(1, 1), a1 + hstep, voffA);
            PG8_WAIT_L(8); PG8_BAR; PG8_WAIT_L(0); PG8_MMA(0, 0, At, B0); PG8_BAR; PG8_SCHED;
            PG8_LDB(B1, 0, 1); PG8_STAGE(PG8_SB(0, 0), b2, voffB);
            PG8_BAR; PG8_WAIT_L(0); PG8_MMA(0, 1, At, B1); PG8_BAR;
            PG8_LDA(At, 0, 1); PG8_STAGE(PG8_SA(0, 0), a2, voffA);
            PG8_BAR; PG8_WAIT_L(0); PG8_MMA(1, 0, At, B0); PG8_BAR; PG8_SCHED;
            PG8_STAGE(PG8_SB(0, 1), b2 + hstep, voffB);
            PG8_WAIT_V(6); PG8_BAR; PG8_MMA(1, 1, At, B1); PG8_BAR;
            PG8_LDB(B0, 1, 0); PG8_SCHED; PG8_LDA(At, 1, 0); PG8_STAGE(PG8_SA(0, 1), a2 + hstep, voffA);
            PG8_WAIT_L(8); PG8_BAR; PG8_WAIT_L(0); PG8_MMA(0, 0, At, B0); PG8_BAR; PG8_SCHED;
            PG8_LDB(B1, 1, 1); PG8_STAGE(PG8_SB(1, 0), b3, voffB);
            PG8_BAR; PG8_WAIT_L(0); PG8_MMA(0, 1, At, B1); PG8_BAR;
            PG8_LDA(At, 1, 1); PG8_STAGE(PG8_SA(1, 0), a3, voffA);
            PG8_BAR; PG8_WAIT_L(0); PG8_MMA(1, 0, At, B0); PG8_BAR; PG8_SCHED;
            PG8_STAGE(PG8_SB(1, 1), b3 + hstep, voffB);
            PG8_WAIT_V(6); PG8_BAR; PG8_MMA(1, 1, At, B1); PG8_BAR;
            }
        }
        if constexpr (ALIGN_EPI) { if (wr == 0) PG8_BAR; }
        if constexpr (!Epi::AFTER_DRAIN) { E(acc, cur, wr, wc, fr, fq); S.done(cur); }
        if (!has_next) break;
#pragma unroll
        for (int a = 0; a < 2; ++a)
#pragma unroll
            for (int b = 0; b < 2; ++b)
#pragma unroll
                for (int m = 0; m < 4; ++m)
#pragma unroll
                    for (int n = 0; n < 2; ++n) acc[a][b][m][n] = (f32x4){0.f, 0.f, 0.f, 0.f};
        cur = nxt; cA = nA; cB = nB; ++ui;
        if constexpr (ALIGN_EPI) { if (wr == 1) PG8_BAR; }
    }
    PG8_WAIT_V(0);
    if constexpr (!ALIGN_EPI) { if (wr == 0) PG8_BAR; }
    PG8_BAR;
    if constexpr (Epi::AFTER_DRAIN) { E.fused(acc, cur, wr, wc, fr, fq, lds, wid, lane); S.done(cur); }
#undef PG8_SA
#undef PG8_SB
#undef PG8_STAGE
#undef PG8_LDA
#undef PG8_LDB
#undef PG8_MMA
#undef PG8_WAIT_V
#undef PG8_WAIT_L
#undef PG8_BAR
#undef PG8_SCHED
}
}

constexpr int BATCH = 16, SEQ = 2048, DM = 1024, M_TOK = BATCH * SEQ, DFF = 2816, NPROJ = 2304, DEPTH = 2;
constexpr float EPS = 1e-6f;
constexpr float C2 = 0.125f * 1.4426950408889634f;

namespace att {
typedef short bf16x8 __attribute__((ext_vector_type(8)));
typedef short s16x4 __attribute__((ext_vector_type(4)));
typedef float f32x16 __attribute__((ext_vector_type(16)));
typedef float f32x4 __attribute__((ext_vector_type(4)));
typedef unsigned u32x4 __attribute__((ext_vector_type(4)));
typedef unsigned short bf16_t;
constexpr int LDQ = NPROJ;
constexpr int SHM_K = 8192, SHM_V = 16384;
constexpr int OFF_K = 0, OFF_V = 2 * SHM_K, OFF_WS = OFF_V + 3 * SHM_V, OFF_O1 = OFF_WS + 8 * 256, LDS_END = OFF_O1 + 8 * 8192;
constexpr float THR2 = 10.f;
#define SBAR() __builtin_amdgcn_sched_barrier(0)
#define KSWZ64(row, colB) ((row) * 128 + ((colB) ^ ((((row) >> 1) & 7) << 4)))
template <int NCB> __device__ __forceinline__ int v_st(int k, int c) { const int kk = (k & ~0xC) | ((k & 4) << 1) | ((k & 8) >> 1); return ((kk >> 3) * NCB + (c >> 5)) * 512 + ((kk & 7) * 32 + (c & 31)) * 2; }
__device__ __forceinline__ int v_rd_base(int lane) { return ((lane & 3) << 3) | (((lane >> 2) & 3) << 6) | (((lane >> 4) & 1) << 5) | (((lane >> 5) & 1) << 8); }
__device__ __forceinline__ int crow(int r, int hi) { return (r & 3) + 8 * (r >> 2) + 4 * hi; }
typedef float f32x2_t __attribute__((ext_vector_type(2))); typedef __bf16 bf16x2_t __attribute__((ext_vector_type(2)));
__device__ __forceinline__ unsigned cvtpk(float lo, float hi) { const f32x2_t v = {lo, hi}; const bf16x2_t b = __builtin_convertvector(v, bf16x2_t); return __builtin_bit_cast(unsigned, b); }
__device__ __forceinline__ void mask_tile(f32x16& p0, f32x16& p1, int dq, unsigned W) {
    const float NEG = -__builtin_inff();
#pragma unroll
    for (int r = 0; r < 16; ++r) { const int c = (r & 3) + 8 * (r >> 2);
        if ((unsigned)(dq - c) >= W) p0[r] = NEG;
        if ((unsigned)(dq - c - 32) >= W) p1[r] = NEG; }
}
__device__ __forceinline__ void qkt(f32x16& p0, f32x16& p1, const char* Kt, int r32, int hi, const bf16x8* qr, const f32x16& negm) {
    bf16x8 kf[8];
#pragma unroll
    for (int d0 = 0; d0 < 4; ++d0) { const char* a = Kt + KSWZ64(r32, d0 * 32 + hi * 16);
        kf[2 * d0] = *reinterpret_cast<const bf16x8*>(a); kf[2 * d0 + 1] = *reinterpret_cast<const bf16x8*>(a + 32 * 128); }
    SBAR();
    __builtin_amdgcn_s_setprio(1);
    p0 = __builtin_amdgcn_mfma_f32_32x32x16_bf16(kf[0], qr[0], negm, 0, 0, 0);
    p1 = __builtin_amdgcn_mfma_f32_32x32x16_bf16(kf[1], qr[0], negm, 0, 0, 0);
#pragma unroll
    for (int d0 = 1; d0 < 4; ++d0) {
        p0 = __builtin_amdgcn_mfma_f32_32x32x16_bf16(kf[2 * d0], qr[d0], p0, 0, 0, 0);
        p1 = __builtin_amdgcn_mfma_f32_32x32x16_bf16(kf[2 * d0 + 1], qr[d0], p1, 0, 0, 0); }
    __builtin_amdgcn_s_setprio(0);
}
__device__ __forceinline__ void softmax_tile(f32x16& p0, f32x16& p1, float& m_reg, float& l_reg, float& alpha, f32x16& negm, bool first, bf16x8& pa0, bf16x8& pa1, bf16x8& pa2, bf16x8& pa3) {
    float pmax = p0[0];
#pragma unroll
    for (int r = 1; r < 16; ++r) pmax = fmaxf(pmax, p0[r]);
#pragma unroll
    for (int r = 0; r < 16; ++r) pmax = fmaxf(pmax, p1[r]);
    { auto rr = __builtin_amdgcn_permlane32_swap(__float_as_uint(pmax), __float_as_uint(pmax), false, false); pmax = fmaxf(__uint_as_float(rr[0]), __uint_as_float(rr[1])); }
    if (!first && __all(pmax <= THR2)) { alpha = 1.f; }
    else {
        const float dl = first ? (pmax > -__builtin_inff() ? pmax : 0.f) : fmaxf(pmax, 0.f);
        alpha = first ? 1.f : __builtin_amdgcn_exp2f(-dl); m_reg += dl;
#pragma unroll
        for (int r = 0; r < 16; ++r) { p0[r] -= dl; p1[r] -= dl; }
#pragma unroll
        for (int r = 0; r < 16; ++r) negm[r] = -m_reg;
    }
#pragma unroll
    for (int r = 0; r < 16; ++r) { p0[r] = __builtin_amdgcn_exp2f(p0[r]); p1[r] = __builtin_amdgcn_exp2f(p1[r]); }
    float ps = 0.f;
#pragma unroll
    for (int r = 0; r < 16; ++r) ps += p0[r] + p1[r];
    { auto rr = __builtin_amdgcn_permlane32_swap(__float_as_uint(ps), __float_as_uint(ps), false, false); ps = __uint_as_float(rr[0]) + __uint_as_float(rr[1]); }
    l_reg = l_reg * alpha + ps;
#define PK4(P, B_, OUT) do { unsigned a0 = cvtpk(P[B_+0], P[B_+1]), a1 = cvtpk(P[B_+2], P[B_+3]); unsigned b0 = cvtpk(P[B_+4], P[B_+5]), b1 = cvtpk(P[B_+6], P[B_+7]); \
        auto r0 = __builtin_amdgcn_permlane32_swap(a0, b0, false, false); auto r1 = __builtin_amdgcn_permlane32_swap(a1, b1, false, false); \
        u32x4 w = {r0[0], r1[0], r0[1], r1[1]}; OUT = *reinterpret_cast<bf16x8*>(&w); } while (0)
    PK4(p0, 0, pa0); PK4(p0, 8, pa1); PK4(p1, 0, pa2); PK4(p1, 8, pa3);
#undef PK4
}
template <int NCB> __device__ __forceinline__ void pv_tile(f32x16* o, int vb, const bf16x8 (&pa)[4]) {
#define TRRD(dst, off) asm volatile("ds_read_b64_tr_b16 %0, %1 offset:%2" : "=&v"(dst) : "v"(vb), "i"(off) : "memory")
#define LWAIT(n) asm volatile("s_waitcnt lgkmcnt(" #n ")" ::: "memory")
    constexpr int G = NCB * 512;
#pragma unroll
    for (int dp = 0; dp < NCB; dp += 2) { s16x4 l[4][2], h[4][2];
#pragma unroll
        for (int ks = 0; ks < 4; ++ks)
#pragma unroll
            for (int e = 0; e < 2; ++e) { TRRD(l[ks][e], (dp + e) * 512 + (2 * ks) * G); TRRD(h[ks][e], (dp + e) * 512 + (2 * ks + 1) * G); }
#define PVM(ks) do { SBAR(); _Pragma("unroll") for (int e = 0; e < 2; ++e) \
            o[dp + e] = __builtin_amdgcn_mfma_f32_32x32x16_bf16(pa[ks], (bf16x8){l[ks][e][0], l[ks][e][1], l[ks][e][2], l[ks][e][3], h[ks][e][0], h[ks][e][1], h[ks][e][2], h[ks][e][3]}, o[dp + e], 0, 0, 0); SBAR(); } while (0)
        LWAIT(12); PVM(0); LWAIT(8); PVM(1); LWAIT(4); PVM(2); LWAIT(0); PVM(3);
#undef PVM
    }
#undef TRRD
#undef LWAIT
}
struct Pre { bf16x8 qr[4]; bf16x8 sk, sv0, sv1; };
template <int DV> __device__ __forceinline__ void attn_core(const bf16_t* Qw, const bf16_t* Kh, const bf16_t* Vh, int qlo, int t_lo, int t_hi, int W, char* lds,
                                                            f32x16 (&o)[DV / 32], float& m_reg, float& l_reg, Pre& pre, bool have_pre, const bf16_t* nQw, const bf16_t* nKh, const bf16_t* nVh, int n_tlo, bool has_next) {
    constexpr int NCB = DV / 32;
    int tid_ = threadIdx.x; asm volatile("" : "+v"(tid_));
    const int tid = tid_, wid = __builtin_amdgcn_readfirstlane(tid >> 6), lane = tid & 63, r32 = lane & 31, hi = lane >> 5;
    char* K_lds = lds + OFF_K; char* V_lds = lds + OFF_V; float* al_l = (float*)(lds + OFF_WS) + wid * 64;
    bf16x8 qr[4];
    if (have_pre) {
#pragma unroll
        for (int d0 = 0; d0 < 4; ++d0) qr[d0] = pre.qr[d0]; }
    else {
#pragma unroll
        for (int d0 = 0; d0 < 4; ++d0) qr[d0] = *reinterpret_cast<const bf16x8*>(Qw + (size_t)r32 * LDQ + d0 * 16 + hi * 8); }
    const int kr = tid >> 3, kc = (tid & 7) * 8, kws = KSWZ64(kr, kc * 2);
    const bf16_t* kg = Kh + (size_t)kr * LDQ + kc;
    int vst0, vst1 = 0; const bf16_t* vg;
    if constexpr (DV == 128) { const int sr = tid >> 4, sc = (tid & 15) * 8; vst0 = v_st<NCB>(sr, sc); vst1 = v_st<NCB>(32 + sr, sc); vg = Vh + (size_t)sr * LDQ + sc; }
    else { const int vr = tid >> 3, vc = (tid & 7) * 8; vst0 = v_st<NCB>(vr, vc); vg = Vh + (size_t)vr * LDQ + vc; }
    const int vb0 = (int)(uintptr_t)V_lds + v_rd_base(lane);
    bf16x8 sk, sv0, sv1 = bf16x8{};
#define SLOAD(t) do { const size_t ro_ = (size_t)(t) * 64 * LDQ; sk = *reinterpret_cast<const bf16x8*>(kg + ro_); sv0 = *reinterpret_cast<const bf16x8*>(vg + ro_); \
        if constexpr (DV == 128) sv1 = *reinterpret_cast<const bf16x8*>(vg + ro_ + (size_t)32 * LDQ); } while (0)
#define SWRITE(kbf, vsl) do { *reinterpret_cast<bf16x8*>(K_lds + (kbf) * SHM_K + kws) = sk; *reinterpret_cast<bf16x8*>(V_lds + (vsl) * SHM_V + vst0) = sv0; \
        if constexpr (DV == 128) *reinterpret_cast<bf16x8*>(V_lds + (vsl) * SHM_V + vst1) = sv1; } while (0)
    if (have_pre) { sk = pre.sk; sv0 = pre.sv0; sv1 = pre.sv1; } else { SLOAD(t_lo); }
    SWRITE(0, 0);
    m_reg = 0.f; l_reg = 0.f; f32x16 negm = f32x16{}; bool first = true;
#pragma unroll
    for (int d = 0; d < NCB; ++d) o[d] = f32x16{};
    __syncthreads();
    const bool grpB = wid >= 4;
    bf16x8 pa[4]; pa[0] = bf16x8{}; pa[1] = bf16x8{}; pa[2] = bf16x8{}; pa[3] = bf16x8{};
    bool pact = false; int kbuf = 0, vs_prev = 2, vs_cur = 0, vs_next = 1;
    for (int t = t_lo; t < t_hi; ++t) {
        const bool more = t + 1 < t_hi;
        if (more) SLOAD(t + 1);
        const int kb = t * 64;
        const bool act = (kb <= qlo + 31) && (kb + 63 >= qlo - W + 1);
        if (grpB && pact) pv_tile<NCB>(o, vb0 + vs_prev * SHM_V, pa);
        if (act) {
            f32x16 p0, p1; float alpha;
            qkt(p0, p1, K_lds + kbuf * SHM_K, r32, hi, qr, negm);
            if (kb + 63 > qlo || kb <= qlo + 31 - W) mask_tile(p0, p1, qlo + r32 - 4 * hi - kb, (unsigned)W);
            softmax_tile(p0, p1, m_reg, l_reg, alpha, negm, first, pa[0], pa[1], pa[2], pa[3]); first = false;
            if (__any(alpha < 1.f)) { if (hi == 0) al_l[r32] = alpha; asm volatile("s_waitcnt lgkmcnt(0)" ::: "memory");
#pragma unroll
                for (int r = 0; r < 16; ++r) { const float f = al_l[crow(r, hi)];
#pragma unroll
                    for (int d = 0; d < NCB; ++d) o[d][r] *= f; } }
            if (!grpB) pv_tile<NCB>(o, vb0 + vs_cur * SHM_V, pa);
        }
        pact = act;
        if (more) SWRITE(kbuf ^ 1, vs_next);
        __syncthreads();
        kbuf ^= 1; vs_prev = vs_cur; vs_cur = vs_next; vs_next = (vs_next == 2) ? 0 : vs_next + 1;
    }
    if (grpB && pact) pv_tile<NCB>(o, vb0 + vs_prev * SHM_V, pa);
    __syncthreads();
    if (has_next) {
#pragma unroll
        for (int d0 = 0; d0 < 4; ++d0) pre.qr[d0] = *reinterpret_cast<const bf16x8*>(nQw + (size_t)r32 * LDQ + d0 * 16 + hi * 8);
        const size_t ro_ = (size_t)n_tlo * 64 * LDQ;
        pre.sk = *reinterpret_cast<const bf16x8*>(nKh + (kg - Kh) + ro_); pre.sv0 = *reinterpret_cast<const bf16x8*>(nVh + (vg - Vh) + ro_);
        if constexpr (DV == 128) pre.sv1 = *reinterpret_cast<const bf16x8*>(nVh + (vg - Vh) + ro_ + (size_t)32 * LDQ); }
#undef SLOAD
#undef SWRITE
}
__device__ __forceinline__ void diff_pair(int b, int h, int s, const bf16_t* PROJ, bf16_t* OB, float lam, float onemli, const float* subg, char* lds) {
    int tid_ = threadIdx.x; asm volatile("" : "+v"(tid_));
    const int tid = tid_, wid = __builtin_amdgcn_readfirstlane(tid >> 6), lane = tid & 63, r32 = lane & 31, hi = lane >> 5;
    const size_t rowb = (size_t)b * SEQ; Pre pre; bool have = false;
    unsigned* o1s = (unsigned*)(lds + OFF_O1) + wid * 2048; float* wsf = (float*)(lds + OFF_WS) + wid * 64;
#pragma unroll 1
    for (int k = 0; k < 4; ++k) { const int mp = k & 1, qb = (k < 2) ? 7 - s : s, q0 = qb * 256, qlo = q0 + wid * 32;
        const int nmp = (k + 1) & 1, nqb = (k + 1 < 2) ? 7 - s : s, nqlo = nqb * 256 + wid * 32; const bool has_next = k < 3;
        const bf16_t* Qw = PROJ + (rowb + qlo) * LDQ + (h * 2 + mp) * 64;
        const bf16_t* Kh = PROJ + rowb * LDQ + 512 + (h * 2 + mp) * 64;
        const bf16_t* Vh = PROJ + rowb * LDQ + 1024 + h * 128;
        f32x16 o[4]; float m_reg, l_reg;
        attn_core<128>(Qw, Kh, Vh, qlo, 0, (q0 + 256) / 64, 1 << 30, lds, o, m_reg, l_reg, pre, have, PROJ + (rowb + nqlo) * LDQ + (h * 2 + nmp) * 64, PROJ + rowb * LDQ + 512 + (h * 2 + nmp) * 64, Vh, 0, has_next);
        have = has_next;
        int lane2 = threadIdx.x & 63; asm volatile("" : "+v"(lane2)); const int lane = lane2, r32 = lane & 31, hi = lane >> 5;
        if (hi == 0) wsf[32 + r32] = l_reg; asm volatile("s_waitcnt lgkmcnt(0)" ::: "memory");
        if (mp == 0) {
#pragma unroll
            for (int r = 0; r < 16; ++r) { const float rl = __builtin_amdgcn_rcpf(wsf[32 + crow(r, hi)]);
                o1s[(r * 2 + 0) * 64 + lane] = cvtpk(o[0][r] * rl, o[1][r] * rl); o1s[(r * 2 + 1) * 64 + lane] = cvtpk(o[2][r] * rl, o[3][r] * rl); }
        } else {
            float g[4];
#pragma unroll
            for (int d = 0; d < 4; ++d) g[d] = subg[d * 32 + r32] * onemli;
            bf16_t* Ow = OB + (rowb + qlo) * DM + h * 128;
#pragma unroll
            for (int r = 0; r < 16; ++r) { const float rl = __builtin_amdgcn_rcpf(wsf[32 + crow(r, hi)]) * lam;
                const unsigned ua = o1s[(r * 2 + 0) * 64 + lane], ub = o1s[(r * 2 + 1) * 64 + lane];
                float v[4]; v[0] = __uint_as_float(ua << 16) - o[0][r] * rl; v[1] = __uint_as_float(ua & 0xffff0000u) - o[1][r] * rl;
                v[2] = __uint_as_float(ub << 16) - o[2][r] * rl; v[3] = __uint_as_float(ub & 0xffff0000u) - o[3][r] * rl;
                float ss = (v[0] * v[0] + v[1] * v[1]) + (v[2] * v[2] + v[3] * v[3]);
#pragma unroll
                for (int x = 1; x < 32; x <<= 1) ss += __shfl_xor(ss, x);
                const float rstd = __builtin_amdgcn_rsqf(ss * (1.f / 128.f) + EPS);
                const int orow = crow(r, hi);
#pragma unroll
                for (int d = 0; d < 4; ++d) { const float val = v[d] * rstd * g[d]; const float vn = __shfl_xor(val, 1);
                    if ((r32 & 1) == 0) __builtin_nontemporal_store(cvtpk(val, vn), (unsigned*)(Ow + (size_t)orow * DM + d * 32 + r32)); } }
        }
    }
}
__device__ __forceinline__ void swa_unit(int b, int kvh, int qblk, const bf16_t* PROJ, bf16_t* OB, const float* sinks, char* lds, Pre& pre, bool have_pre, int nu, bool has_next) {
    const int wid = __builtin_amdgcn_readfirstlane(threadIdx.x >> 6);
    const int j = kvh * 4 + (wid >> 1);
    const size_t rowb = (size_t)b * SEQ; const int q0 = qblk * 64, qlo = q0 + (wid & 1) * 32; float* wsf = (float*)(lds + OFF_WS) + wid * 64;
    const bf16_t* Qw = PROJ + (rowb + qlo) * LDQ + 1536 + 64 * j;
    const bf16_t* Kh = PROJ + rowb * LDQ + 2048 + 64 * kvh;
    const bf16_t* Vh = PROJ + rowb * LDQ + 2176 + 64 * kvh;
    const float sink2 = sinks[j] * 1.4426950408889634f;
    f32x16 o[2]; float m_reg, l_reg;
    const int t_lo = qblk - 2 < 0 ? 0 : qblk - 2;
    const int nb = nu >> 6, nkvh = (nu >> 5) & 1, nqblk = nu & 31, nj = nkvh * 4 + (wid >> 1);
    const size_t nrowb = (size_t)nb * SEQ;
    attn_core<64>(Qw, Kh, Vh, qlo, t_lo, qblk + 1, 128, lds, o, m_reg, l_reg, pre, have_pre, PROJ + (nrowb + nqblk * 64 + (wid & 1) * 32) * LDQ + 1536 + 64 * nj,
                  PROJ + nrowb * LDQ + 2048 + 64 * nkvh, PROJ + nrowb * LDQ + 2176 + 64 * nkvh, nqblk - 2 < 0 ? 0 : nqblk - 2, has_next);
    int lane2 = threadIdx.x & 63; asm volatile("" : "+v"(lane2)); const int r32 = lane2 & 31, hi = lane2 >> 5;
    const float lt = l_reg + __builtin_amdgcn_exp2f(sink2 - m_reg);
    if (hi == 0) wsf[32 + r32] = lt; asm volatile("s_waitcnt lgkmcnt(0)" ::: "memory");
    bf16_t* Ow = OB + (rowb + qlo) * DM + 512 + 64 * j;
#pragma unroll
    for (int r = 0; r < 16; ++r) { const float rl = __builtin_amdgcn_rcpf(wsf[32 + crow(r, hi)]); const int orow = crow(r, hi);
#pragma unroll
        for (int d = 0; d < 2; ++d) { const float val = o[d][r] * rl; const float vn = __shfl_xor(val, 1);
            if ((r32 & 1) == 0) __builtin_nontemporal_store(cvtpk(val, vn), (unsigned*)(Ow + (size_t)orow * DM + d * 32 + r32)); } }
}
#undef SBAR
}

typedef unsigned short bf16;
typedef float f32x4 __attribute__((ext_vector_type(4)));
typedef unsigned v4u __attribute__((ext_vector_type(4)));
typedef unsigned v2u __attribute__((ext_vector_type(2)));
constexpr int NWAVES = 8;
constexpr size_t MiB = 1u << 20;
constexpr size_t WS_CTL = 1536 * 1024, CTL_BYTES = 16384;
constexpr size_t WS_MOD = 0, WS_ROPE = 1 * MiB, WS_W = 2 * MiB, W_LAYER = 23 * MiB;
constexpr size_t WO_IN = 0, WO_OUT = 4608 * 1024, WO_GU = WO_OUT + 2 * MiB, WO_DOWN = WO_GU + 11 * MiB;
constexpr size_t WS_XN = 48 * MiB, WS_PROJ = 112 * MiB, WS_O = 256 * MiB, WS_Y = 320 * MiB, WS_H = 112 * MiB, WS_XH = 384 * MiB, WS_END = 448 * MiB;
static_assert(WO_DOWN + (size_t)DM * DFF * 2 <= W_LAYER && WS_W + 2 * W_LAYER <= WS_XN && WS_H + (size_t)M_TOK * DFF * 2 <= WS_Y, "ws map");
constexpr int LDS_BYTES = 136 * 1024, MISC_OFF = 135 * 1024;
static_assert(att::LDS_END <= MISC_OFF && pg8::STAGE_BYTES <= MISC_OFF && MISC_OFF + 128 <= LDS_BYTES && 3456 * 4 <= (int)CTL_BYTES, "lds map");

__device__ __forceinline__ float wave_sum(float v) {
#pragma unroll
    for (int o = 1; o < 64; o <<= 1) v += __shfl_xor(v, o);
    return v;
}
__device__ __forceinline__ unsigned pk2(float lo, float hi) { unsigned r; asm volatile("v_cvt_pk_bf16_f32 %0, %1, %2" : "=v"(r) : "v"(lo), "v"(hi)); return r; }

__device__ __forceinline__ void transpose_item(const float* W, int K, int N, bf16* WT, int kind, float* scr, int item, int lane) {
    const int nblk = N / 32, kb = item / nblk, nb = item % nblk, k0 = 64 * kb, n0 = 32 * nb;
    int drow0 = n0;
    if (kind == 0) { const int pn = n0 >> 8, c = n0 & 255; int j;
        if (pn == 4 || pn == 5) j = c;
        else if (pn == 8 && c >= 128) { const int vv = c - 128; j = 128 * (vv >> 6) + 64 + (vv & 63); }
        else { j = 128 * ((c >> 5) & 1) + 32 * (c >> 6); }
        drow0 = 256 * pn + j; }
    else if (kind == 2) drow0 = 256 * (n0 >> 7) + (n0 & 127);
    else if (kind == 3) drow0 = 256 * (n0 >> 7) + 128 + (n0 & 127);
    { float wv[32];
#pragma unroll
        for (int i = 0; i < 32; ++i) wv[i] = __builtin_nontemporal_load(W + (size_t)(k0 + 2 * i + (lane >> 5)) * N + n0 + (lane & 31));
#pragma unroll
        for (int i = 0; i < 32; ++i) scr[(2 * i + (lane >> 5)) * 33 + (lane & 31)] = wv[i]; }
    asm volatile("s_waitcnt lgkmcnt(0)" ::: "memory");
    const int c = lane & 7;
#pragma unroll
    for (int j = 0; j < 4; ++j) { const int n = (lane >> 3) + 8 * j; const float* s = scr + (8 * c) * 33 + n;
        v4u o; o.x = pk2(s[0 * 33], s[1 * 33]); o.y = pk2(s[2 * 33], s[3 * 33]); o.z = pk2(s[4 * 33], s[5 * 33]); o.w = pk2(s[6 * 33], s[7 * 33]);
        *(v4u*)(WT + (size_t)(drow0 + n) * K + k0 + 8 * c) = o; }
    asm volatile("s_waitcnt lgkmcnt(0)" ::: "memory");
}


#define LAS __attribute__((address_space(3)))
#define XB_TMO      128
#define XB_XCNT(j)  (256  + 64 * (j))
#define XB_XSUB(j)  (1280 + 64 * (j))
#define XB_XGEN(j)  (2304 + 64 * (j))
#define XB_TOP      3328
#define XB_TOPGEN   3392
#define XCD_BAR_WORDS 3456
#define XB_SPIN_CAP (1u << 18)

__device__ __forceinline__ unsigned xb_ld(unsigned* p)              { return __hip_atomic_load(p, __ATOMIC_RELAXED, __HIP_MEMORY_SCOPE_AGENT); }
__device__ __forceinline__ unsigned xb_add(unsigned* p, unsigned v) { return __hip_atomic_fetch_add(p, v, __ATOMIC_RELAXED, __HIP_MEMORY_SCOPE_AGENT); }
__device__ __forceinline__ unsigned xb_xcc_id() { return (unsigned)__builtin_amdgcn_s_getreg((3 << 11) | 20) & 0xFu; }
#define XB_SPIN(cond, bar) do { unsigned _sp = 0; while (cond) { __builtin_amdgcn_s_sleep(1); \
    if ((++_sp & 255u) == 0u) { if (xb_ld(&(bar)[XB_TMO])) break; if (_sp > XB_SPIN_CAP) { atomicAdd(&(bar)[XB_TMO], 1u); break; } } } } while (0)

struct XcdBarrier {
    unsigned* bar; unsigned x;
    volatile LAS unsigned* st;
};

__device__ __forceinline__ XcdBarrier xcd_barrier_post(unsigned* bar, volatile LAS unsigned* st) {
    XcdBarrier b; b.bar = bar; b.x = xb_xcc_id(); b.st = st;
    if (threadIdx.x == 0) (void)xb_add(&bar[XB_XCNT(b.x)], 1u);
    return b;
}
__device__ __forceinline__ void xcd_barrier_complete(unsigned* bar, unsigned x, unsigned& nloc, unsigned& nx) {
    const unsigned G = gridDim.x * gridDim.y * gridDim.z;
    unsigned sum, cnt, mine, sp = 0u;
    for (;;) {
        sum = 0u; cnt = 0u; mine = 0u;
#pragma unroll
        for (unsigned j = 0; j < 16; ++j) { const unsigned c = xb_ld(&bar[XB_XCNT(j)]); sum += c; cnt += (c > 0u) ? 1u : 0u; mine = (j == x) ? c : mine; }
        if (sum == G) break;
        __builtin_amdgcn_s_sleep(1);
        if ((++sp & 255u) == 0u) { if (xb_ld(&bar[XB_TMO])) break; if (sp > XB_SPIN_CAP) { atomicAdd(&bar[XB_TMO], 1u); break; } }
    }
    nloc = mine > 0u ? mine : 1u; nx = cnt > 0u ? cnt : 1u;
}

__device__ __forceinline__ void xcd_barrier(const XcdBarrier& b) {
    asm volatile("s_waitcnt vmcnt(0)" ::: "memory");
    __syncthreads();
    if (threadIdx.x < 64 && b.st[0] == 0u) {
        unsigned* bar = b.bar; const unsigned G = gridDim.x * gridDim.y * gridDim.z; unsigned c, sum, sp = 0u;
        for (;;) {
            c = (threadIdx.x < 16) ? xb_ld(&bar[XB_XCNT(threadIdx.x)]) : 0u; sum = c;
#pragma unroll
            for (int o = 1; o < 64; o <<= 1) sum += (unsigned)__shfl_xor((int)sum, o);
            if (sum == G) break;
            __builtin_amdgcn_s_sleep(1);
            if ((++sp & 255u) == 0u) { if (xb_ld(&bar[XB_TMO])) break; if (sp > XB_SPIN_CAP) { if (threadIdx.x == 0) atomicAdd(&bar[XB_TMO], 1u); break; } }
        }
        const unsigned cnt = (unsigned)__popcll(__ballot(c > 0u)), mine = (unsigned)__shfl((int)c, (int)b.x);
        if (threadIdx.x == 0) { b.st[0] = mine > 0u ? mine : 1u; b.st[1] = cnt > 0u ? cnt : 1u; }
        asm volatile("s_waitcnt lgkmcnt(0)" ::: "memory");
    }
    if (threadIdx.x == 0) {
        unsigned* bar = b.bar;
        __builtin_amdgcn_s_waitcnt(0);
        unsigned nloc = b.st[0], nx = b.st[1];
        if (nloc == 0u) { xcd_barrier_complete(bar, b.x, nloc, nx); b.st[0] = nloc; b.st[1] = nx; }
        const unsigned old = xb_add(&bar[XB_XSUB(b.x)], 1u);
        const unsigned gen = old / nloc;
        if (old + 1u == (gen + 1u) * nloc) {
            __builtin_amdgcn_fence(__ATOMIC_RELEASE, "agent");
            asm volatile("s_waitcnt vmcnt(0)" ::: "memory");
            const unsigned og = xb_add(&bar[XB_TOP], 1u);
            const unsigned tg = og / nx;
            if (og + 1u == (tg + 1u) * nx) xb_add(&bar[XB_TOPGEN], 1u);
            else XB_SPIN(xb_ld(&bar[XB_TOPGEN]) == tg, bar);
            __builtin_amdgcn_fence(__ATOMIC_ACQUIRE, "agent");
            xb_add(&bar[XB_XGEN(b.x)], 1u);
            asm volatile("s_waitcnt vmcnt(0)" ::: "memory");
        } else {
            XB_SPIN(xb_ld(&bar[XB_XGEN(b.x)]) == gen, bar);
            __builtin_amdgcn_fence(__ATOMIC_ACQUIRE, "agent");
            asm volatile("s_waitcnt vmcnt(0)" ::: "memory");
        }
    }
    __syncthreads();
}

#ifndef REP_P0
#define REP_P0 1
#endif
#ifndef REP_E0
#define REP_E0 1
#endif
#ifndef REP_G1
#define REP_G1 1
#endif
#ifndef REP_ATT
#define REP_ATT 1
#endif
#ifndef REP_G2
#define REP_G2 1
#endif
#ifndef REP_G3
#define REP_G3 1
#endif
#ifndef REP_E1
#define REP_E1 1
#endif
#ifndef REP_SYNC
#define REP_SYNC 0
#endif
#ifndef REP_G4
#define REP_G4 1
#endif
#define REPEAT(n) _Pragma("unroll 1") for (int rep_ = 0; rep_ < (n); ++rep_)
struct Args { const float* in[19]; float* out; unsigned char* ws; int ph_lo, ph_hi; };
enum { I_X = 0, I_C, I_ADAW, I_ADAB, I_GMPRE, I_GMPOST, I_GFPRE, I_GFPOST, I_WIN, I_LQ1, I_LK1, I_LQ2, I_LK2, I_SUBG, I_SINKS, I_WOUT, I_WGATE, I_WUP, I_WDOWN };

typedef _Float16 h16x4 __attribute__((ext_vector_type(4)));
template <bool XIN_H, bool XOUT_H>
__device__ __forceinline__ void ew_phase(const void* xin_, void* xout_, const bf16* Y, const float* gpost, const float* gate, const float* gpre, const float* scv, const float* shv,
                                         bf16* XN, bool has_res, bool has_norm, int gw, int NGW, int lane_) {
    int lane = threadIdx.x & 63; asm volatile("" : "+v"(lane)); (void)lane_;
    constexpr int R = XIN_H ? 8 : 4;
    typedef typename std::conditional<XIN_H, h16x4, f32x4>::type xraw_t;
    for (int r0 = gw * R; r0 < M_TOK; r0 += NGW * R) {
        const int b = r0 >> 11; const size_t ro = (size_t)r0 * DM + 4 * lane, vo = (size_t)b * 6144 + 4 * lane;
        xraw_t xr[R][4]; v2u yw[R][4];
#pragma unroll
        for (int k = 0; k < R; ++k)
#pragma unroll
            for (int j = 0; j < 4; ++j) xr[k][j] = __builtin_nontemporal_load((const xraw_t*)xin_ + (ro + (size_t)k * DM + 256 * j) / 4);
        if (has_res) {
#pragma unroll
            for (int k = 0; k < R; ++k)
#pragma unroll
                for (int j = 0; j < 4; ++j) yw[k][j] = __builtin_nontemporal_load((const v2u*)(Y + ro + (size_t)k * DM + 256 * j));
        }
        f32x4 gp[4], gq[4], sh[4];
        if (has_res) {
#pragma unroll
            for (int j = 0; j < 4; ++j) gp[j] = *(const f32x4*)(gpost + 4 * lane + 256 * j) * *(const f32x4*)(gate + vo + 256 * j); }
        if (has_norm) {
#pragma unroll
            for (int j = 0; j < 4; ++j) { gq[j] = *(const f32x4*)(gpre + 4 * lane + 256 * j) * (*(const f32x4*)(scv + vo + 256 * j) + 1.0f); sh[j] = *(const f32x4*)(shv + vo + 256 * j); } }
#pragma unroll
        for (int k = 0; k < R; ++k) { f32x4 x[4];
#pragma unroll
            for (int j = 0; j < 4; ++j) { if constexpr (XIN_H) x[j] = __builtin_convertvector(xr[k][j], f32x4); else x[j] = xr[k][j]; }
            if (has_res) { f32x4 y[4]; float ss = 0.f;
#pragma unroll
                for (int j = 0; j < 4; ++j) { const v2u w = yw[k][j];
                    y[j] = (f32x4){__uint_as_float(w.x << 16), __uint_as_float(w.x & 0xffff0000u), __uint_as_float(w.y << 16), __uint_as_float(w.y & 0xffff0000u)};
                    ss += (y[j].x * y[j].x + y[j].y * y[j].y) + (y[j].z * y[j].z + y[j].w * y[j].w); }
                const float rstd = __builtin_amdgcn_rsqf(wave_sum(ss) * (1.f / DM) + EPS);
#pragma unroll
                for (int j = 0; j < 4; ++j) { x[j] = x[j] + gp[j] * (y[j] * rstd);
                    if constexpr (XOUT_H) { const h16x4 hx = __builtin_convertvector(x[j], h16x4); __builtin_nontemporal_store(hx, (h16x4*)((_Float16*)xout_ + ro + (size_t)k * DM + 256 * j));
                        x[j] = __builtin_convertvector(hx, f32x4); }
                    else __builtin_nontemporal_store(x[j], (f32x4*)((float*)xout_ + ro + (size_t)k * DM + 256 * j)); } }
            if (has_norm) { float ss = 0.f;
#pragma unroll
                for (int j = 0; j < 4; ++j) ss += (x[j].x * x[j].x + x[j].y * x[j].y) + (x[j].z * x[j].z + x[j].w * x[j].w);
                const float rstd = __builtin_amdgcn_rsqf(wave_sum(ss) * (1.f / DM) + EPS);
#pragma unroll
                for (int j = 0; j < 4; ++j) { const f32x4 hv = (x[j] * rstd) * gq[j] + sh[j]; v2u w; w.x = pk2(hv.x, hv.y); w.y = pk2(hv.z, hv.w); *(v2u*)(XN + ro + (size_t)k * DM + 256 * j) = w; } }
        }
    }
}

constexpr int CONV_I_IN = (DM / 64) * (NPROJ / 32), CONV_I_OUT = (DM / 64) * (DM / 32), CONV_I_G = (DM / 64) * (DFF / 32), CONV_I_D = (DFF / 64) * (DM / 32), CONV_I_LAYER = CONV_I_IN + CONV_I_OUT + 2 * CONV_I_G + CONV_I_D;
constexpr int CONV_URGENT = CONV_I_IN, CONV_TOTAL = DEPTH * CONV_I_LAYER;
__device__ __forceinline__ void convert_weights(const Args& a, unsigned char* ws, float* scr, int it_lo, int it_hi, int iw, int nw, int lane) {
    for (int it = it_lo + iw; it < it_hi; it += nw) {
        const int l = it / CONV_I_LAYER; int r = it % CONV_I_LAYER; unsigned char* wb = ws + WS_W + (size_t)l * W_LAYER;
        if (r < CONV_I_IN) { transpose_item(a.in[I_WIN] + (size_t)l * DM * NPROJ, DM, NPROJ, (bf16*)(wb + WO_IN), 0, scr, r, lane); continue; } r -= CONV_I_IN;
        if (r < CONV_I_OUT) { transpose_item(a.in[I_WOUT] + (size_t)l * DM * DM, DM, DM, (bf16*)(wb + WO_OUT), 1, scr, r, lane); continue; } r -= CONV_I_OUT;
        if (r < CONV_I_G) { transpose_item(a.in[I_WGATE] + (size_t)l * DM * DFF, DM, DFF, (bf16*)(wb + WO_GU), 2, scr, r, lane); continue; } r -= CONV_I_G;
        if (r < CONV_I_G) { transpose_item(a.in[I_WUP] + (size_t)l * DM * DFF, DM, DFF, (bf16*)(wb + WO_GU), 3, scr, r, lane); continue; } r -= CONV_I_G;
        transpose_item(a.in[I_WDOWN] + (size_t)l * DFF * DM, DFF, DM, (bf16*)(wb + WO_DOWN), 1, scr, r, lane);
    }
}

__global__ void __launch_bounds__(NWAVES * 64, 2) fwd_mega(Args a) {
    extern __shared__ __attribute__((aligned(16))) unsigned char lds[];
    cg::grid_group grid = cg::this_grid();
    const int wid = __builtin_amdgcn_readfirstlane(threadIdx.x >> 6);
#define FRESH_TID() int tid = threadIdx.x; asm volatile("" : "+v"(tid)); const int lane = tid & 63; (void)lane
    const int G = gridDim.x, gw = blockIdx.x * NWAVES + wid, NGW = G * NWAVES;
    unsigned char* ws = a.ws;
    float* MOD = (float*)(ws + WS_MOD); float* ROPE_C = (float*)(ws + WS_ROPE); float* ROPE_S = ROPE_C + SEQ * 32;
    bf16* XN = (bf16*)(ws + WS_XN); bf16* PROJ = (bf16*)(ws + WS_PROJ); bf16* OB = (bf16*)(ws + WS_O); bf16* YB = (bf16*)(ws + WS_Y); bf16* HB = (bf16*)(ws + WS_H);
    const int lo = a.ph_lo, hi_ph = a.ph_hi;
    volatile LAS unsigned* MISC = (volatile LAS unsigned*)((LAS unsigned char*)lds + MISC_OFF);
    if (threadIdx.x < 32) MISC[threadIdx.x] = 0u;
    __syncthreads();
    XcdBarrier bar = xcd_barrier_post((unsigned*)(ws + WS_CTL), MISC + 8);
#define IN(k) (lo <= (k) && (k) < hi_ph)
#define SEAM(k) do { if (IN(k) && IN((k) + 1)) xcd_barrier(bar); } while (0)
    if (hi_ph > 4096) grid.sync();

    if (IN(0)) REPEAT(REP_P0) { FRESH_TID();
        for (int u = blockIdx.x; u < 192; u += G) {
            const int l = u / 96, col0 = (u % 96) * 64;
            float* cs = (float*)lds + wid * 2048; float* part = (float*)lds + 16384;
            { float cv[32];
#pragma unroll
                for (int i = 0; i < 32; ++i) { const int ix = lane + 64 * i; cv[i] = a.in[I_C][(ix >> 7) * DM + wid * 128 + (ix & 127)]; }
#pragma unroll
                for (int i = 0; i < 32; ++i) cs[lane + 64 * i] = cv[i] / (1.0f + __expf(-cv[i])); }
            asm volatile("s_waitcnt lgkmcnt(0)" ::: "memory");
            float acc[16];
#pragma unroll
            for (int b = 0; b < 16; ++b) acc[b] = 0.f;
            const float* wp = a.in[I_ADAW] + ((size_t)l * DM + wid * 128) * 6144 + col0 + lane;
#pragma unroll 1
            for (int d0 = 0; d0 < 128; d0 += 16) { float w[16];
#pragma unroll
                for (int i = 0; i < 16; ++i) w[i] = __builtin_nontemporal_load(wp + (size_t)(d0 + i) * 6144);
#pragma unroll
                for (int i = 0; i < 16; ++i)
#pragma unroll
                    for (int b = 0; b < 16; ++b) acc[b] += cs[b * 128 + d0 + i] * w[i]; }
#pragma unroll
            for (int b = 0; b < 16; ++b) part[(wid * 16 + b) * 64 + lane] = acc[b];
            __syncthreads();
            for (int idx = tid; idx < 1024; idx += 512) { const int b = idx >> 6, cl = idx & 63; float s = a.in[I_ADAB][l * 6144 + col0 + cl];
#pragma unroll
                for (int w = 0; w < 8; ++w) s += part[(w * 16 + b) * 64 + cl];
                MOD[((size_t)l * 16 + b) * 6144 + col0 + cl] = s; }
            __syncthreads();
        }
    }
    SEAM(0);
    if (IN(1)) REPEAT(REP_E0) { FRESH_TID();
        for (int idx = blockIdx.x * 512 + tid; idx < SEQ * 32; idx += G * 512) {
            const int pos = idx >> 5, i = idx & 31;
            double inv = 1.0; const double rr = 0.74989420933245582730;
            for (int k = 0; k < i; ++k) inv *= rr;
            const float ang = (float)pos * (float)inv;
            const double rev = (double)ang * 0.15915494309189533577, fr = rev - __builtin_rint(rev);
            const double q4 = __builtin_rint(fr * 4.0); const double t = (fr - q4 * 0.25) * 6.28318530717958647692; const int k4 = ((int)q4) & 3;
            const double t2 = t * t;
            const double sn = t * (1.0 + t2 * (-1.0 / 6 + t2 * (1.0 / 120 + t2 * (-1.0 / 5040 + t2 * (1.0 / 362880 + t2 * (-1.0 / 39916800 + t2 * (1.0 / 6227020800.0)))))));
            const double cn = 1.0 + t2 * (-0.5 + t2 * (1.0 / 24 + t2 * (-1.0 / 720 + t2 * (1.0 / 40320 + t2 * (-1.0 / 3628800 + t2 * (1.0 / 479001600.0))))));
            const double S = (k4 == 0) ? sn : (k4 == 1) ? cn : (k4 == 2) ? -sn : -cn, C = (k4 == 0) ? cn : (k4 == 1) ? -sn : (k4 == 2) ? -cn : sn;
            ROPE_C[idx] = (float)C; ROPE_S[idx] = (float)S;
        }
        convert_weights(a, ws, (float*)(lds + wid * 16384), 0, CONV_URGENT, gw, NGW, lane);
        __syncthreads();
        ew_phase<false, false>(a.in[I_X], nullptr, nullptr, nullptr, nullptr, a.in[I_GMPRE], MOD + 1 * DM, MOD + 0 * DM, XN, false, true, gw, NGW, 0);
    }
    SEAM(1);
    REPEAT(REP_SYNC) xcd_barrier(bar);
#pragma unroll 1
    for (int l = 0; l < DEPTH; ++l) {
        const int pb = 2 + 7 * l;
#define FRESH_WS() size_t z_ = 0; asm volatile("" : "+s"(z_)); unsigned char* ws_ = ws + z_; unsigned char* wb = ws_ + WS_W + (size_t)l * W_LAYER; float* modl = (float*)(ws_ + WS_MOD) + (size_t)l * 16 * 6144; \
        bf16* XN = (bf16*)(ws_ + WS_XN); bf16* PROJ = (bf16*)(ws_ + WS_PROJ); bf16* OB = (bf16*)(ws_ + WS_O); bf16* YB = (bf16*)(ws_ + WS_Y); bf16* HB = (bf16*)(ws_ + WS_H); \
        float* ROPE_C = (float*)(ws_ + WS_ROPE); float* ROPE_S = ROPE_C + SEQ * 32; float* MOD = (float*)(ws_ + WS_MOD); float* out_ = a.out + z_; \
        (void)wb; (void)modl; (void)XN; (void)PROJ; (void)OB; (void)YB; (void)HB; (void)ROPE_C; (void)ROPE_S; (void)MOD; (void)out_
        if (IN(pb + 0)) REPEAT(REP_G1) { FRESH_WS(); pg8::Gemm g{XN, (const bf16*)(wb + WO_IN), M_TOK, NPROJ, DM}; pg8::StaticOrder S; S.init(M_TOK, NPROJ, G, (int)blockIdx.x);
            pg8::EpiProj E{PROJ, ROPE_C, ROPE_S, C2};
#ifndef NO_G1
            pg8::gemm_phase<pg8::EpiProj, pg8::StaticOrder, true, true>((PG8_LAS unsigned char*)lds, g, S, E);
#endif
            { const int nu = (M_TOK / 256) * (NPROJ / 256), rem = nu % G;
              if (l == 0 && rem != 0 && (int)blockIdx.x >= rem) { FRESH_TID(); convert_weights(a, ws_, (float*)(lds + wid * 16384), CONV_URGENT, CONV_TOTAL, ((int)blockIdx.x - rem) * NWAVES + wid, (G - rem) * NWAVES, lane); }
              else if (l == 0 && rem == 0) { FRESH_TID(); convert_weights(a, ws_, (float*)(lds + wid * 16384), CONV_URGENT, CONV_TOTAL, gw, NGW, lane); } }
 }
        SEAM(pb + 0);
        if (IN(pb + 1)) REPEAT(REP_ATT) { FRESH_WS(); FRESH_TID();
            const float s1 = wave_sum(a.in[I_LQ1][l * 64 + lane] * a.in[I_LK1][l * 64 + lane]), s2 = wave_sum(a.in[I_LQ2][l * 64 + lane] * a.in[I_LK2][l * 64 + lane]);
            const float lam_init = (l == 0) ? 0.2f : 0.35550906759096924f;
            const float lam = __expf(s1) - __expf(s2) + lam_init;
            for (int u = blockIdx.x; u < 256; u += G) { const int bh = (u & 7) * 8 + (u >> 5), b = bh >> 2, h = bh & 3, s = (u >> 3) & 3;
#ifndef NO_DIFF
                att::diff_pair(b, h, s, PROJ, OB, lam, 1.0f - lam_init, a.in[I_SUBG] + l * 128, (char*)lds);
#endif
 }
            att::Pre spre; bool shave = false;
            for (int u = blockIdx.x; u < 1024; u += G) { const int cmb = (u & 7) * 4 + (u >> 8), b = cmb >> 1, kvh = cmb & 1, qblk = (u >> 3) & 31; const bool snext = u + G < 1024;
#ifndef NO_SWA
                att::swa_unit(b, kvh, qblk, PROJ, OB, a.in[I_SINKS] + l * 8, (char*)lds, spre, false, u, false); (void)shave; (void)snext;
#endif
 }
        }
        SEAM(pb + 1);
        if (IN(pb + 2)) REPEAT(REP_G2) { FRESH_WS(); pg8::Gemm g{OB, (const bf16*)(wb + WO_OUT), M_TOK, DM, DM}; pg8::StaticOrder S; S.init(M_TOK, DM, G, (int)blockIdx.x);
            pg8::EpiPlain E{YB, DM};
            pg8::gemm_phase<pg8::EpiPlain, pg8::StaticOrder, true, true>((PG8_LAS unsigned char*)lds, g, S, E); }
        SEAM(pb + 2);
        if (IN(pb + 3)) REPEAT(l == 0 ? REP_E1 : 1) { FRESH_WS(); _Float16* XH = (_Float16*)(ws_ + WS_XH);
            if (l == 0) ew_phase<false, true>(a.in[I_X] + z_, XH, YB, a.in[I_GMPOST] + l * DM, modl + 2 * DM, a.in[I_GFPRE] + l * DM, modl + 4 * DM, modl + 3 * DM, XN, true, true, gw, NGW, 0);
            else ew_phase<true, true>(XH, XH, YB, a.in[I_GMPOST] + l * DM, modl + 2 * DM, a.in[I_GFPRE] + l * DM, modl + 4 * DM, modl + 3 * DM, XN, true, true, gw, NGW, 0); }
        SEAM(pb + 3);
        if (IN(pb + 4)) REPEAT(REP_G3) { FRESH_WS(); pg8::Gemm g{XN, (const bf16*)(wb + WO_GU), M_TOK, 2 * DFF, DM}; pg8::StaticOrder S; S.init(M_TOK, 2 * DFF, G, (int)blockIdx.x);
            pg8::EpiSwiglu E{HB, DFF};
#ifndef NO_G3
            pg8::gemm_phase<pg8::EpiSwiglu, pg8::StaticOrder, true, true>((PG8_LAS unsigned char*)lds, g, S, E);
#endif
 }
        SEAM(pb + 4);
        if (IN(pb + 5)) REPEAT(REP_G4) { FRESH_WS(); pg8::Gemm g{HB, (const bf16*)(wb + WO_DOWN), M_TOK, DM, DFF}; pg8::StaticOrder S; S.init(M_TOK, DM, G, (int)blockIdx.x);
            pg8::EpiPlain E{YB, DM};
            pg8::gemm_phase<pg8::EpiPlain, pg8::StaticOrder, true, true>((PG8_LAS unsigned char*)lds, g, S, E); }
        SEAM(pb + 5);
        if (IN(pb + 6)) { FRESH_WS(); const int ln = (l + 1 < DEPTH) ? l + 1 : l; float* modn = MOD + (size_t)ln * 16 * 6144;
            _Float16* XH = (_Float16*)(ws_ + WS_XH);
            if (l + 1 < DEPTH) ew_phase<true, true>(XH, XH, YB, a.in[I_GFPOST] + l * DM, modl + 5 * DM, a.in[I_GMPRE] + ln * DM, modn + 1 * DM, modn + 0 * DM, XN, true, true, gw, NGW, 0);
            else ew_phase<true, false>(XH, out_, YB, a.in[I_GFPOST] + l * DM, modl + 5 * DM, a.in[I_GMPRE] + ln * DM, modn + 1 * DM, modn + 0 * DM, XN, true, false, gw, NGW, 0); }
        SEAM(pb + 6);
    }
#undef IN
#undef SEAM
}

constexpr int N_PHASES = 2 + 7 * DEPTH;
#ifndef MK_COOP
#define MK_COOP 1
#endif
extern "C" void kernel_launch(void* const* d_in, const int* in_sizes, int n_in, void* d_out, int out_size, void* d_ws, size_t ws_size, hipStream_t stream) {
    static int grid = 0;
    if (grid == 0) {
        if (n_in != 19 || in_sizes[0] != M_TOK * DM || out_size != M_TOK * DM || ws_size < WS_END) { fprintf(stderr, "kernel_launch: unexpected shapes (n_in %d, ws %zu)\n", n_in, ws_size); grid = -1; return; }
        int dev = 0, cus = 0, per_cu = 0;
        (void)hipGetDevice(&dev); (void)hipDeviceGetAttribute(&cus, hipDeviceAttributeMultiprocessorCount, dev);
        if (hipFuncSetAttribute((const void*)fwd_mega, hipFuncAttributeMaxDynamicSharedMemorySize, LDS_BYTES) != hipSuccess) { fprintf(stderr, "kernel_launch: hipFuncSetAttribute failed\n"); grid = -1; return; }
        if (hipOccupancyMaxActiveBlocksPerMultiprocessor(&per_cu, (const void*)fwd_mega, NWAVES * 64, LDS_BYTES) != hipSuccess || per_cu < 1) { fprintf(stderr, "kernel_launch: occupancy query says %d\n", per_cu); (void)hipGetLastError(); grid = -1; return; }
        grid = cus;
    }
    if (grid < 0) return;
    if (hipMemsetAsync((char*)d_ws + WS_CTL, 0, CTL_BYTES, stream) != hipSuccess) { fprintf(stderr, "kernel_launch: memset failed\n"); return; }
    Args a{};
    for (int i = 0; i < 19; ++i) a.in[i] = (const float*)d_in[i];
    a.out = (float*)d_out; a.ws = (unsigned char*)d_ws;
#if MK_COOP
    a.ph_lo = 0; a.ph_hi = N_PHASES;
    void* args[] = {&a};
    hipError_t e = hipLaunchCooperativeKernel((const void*)fwd_mega, dim3(grid), dim3(NWAVES * 64), args, LDS_BYTES, stream);
    if (e != hipSuccess) fprintf(stderr, "kernel_launch: cooperative launch failed: %s (grid %d)\n", hipGetErrorString(e), grid);
#else
    for (int p = 0; p < N_PHASES; ++p) { a.ph_lo = p; a.ph_hi = p + 1; hipLaunchKernelGGL(fwd_mega, dim3(grid), dim3(NWAVES * 64), LDS_BYTES, stream, a); }
#endif
}
```
